# Optimizing an MI355X kernel written in HIP

```python
import jax, jax.numpy as jnp
from jax import lax
import numpy as np

D_MODEL = 2048
BATCH = 16
SEQ = 2048
DEPTH = 4

CHUNK = 64
Q_BLOCK = 128
HEAD_DIM = 128
H_SB = 6
H_DIFF = 5
H_FOX = 5
DIFF_DIM = HEAD_DIM // 2
D_SB = H_SB * HEAD_DIM
D_DIFF = H_DIFF * HEAD_DIM
D_FOX = H_FOX * HEAD_DIM
N_BRANCH = 3
D_IN = 3 * D_SB + 3 * D_DIFF + 3 * D_FOX + H_FOX
D_FF = -(-8 * D_MODEL // (3 * 256)) * 256
EPS = 1e-6
ALIBI_MAX = 8.0

kernel_name = "hybrid_stickbreak_diff_fox_trunk"


def _rms(x, g):
    xf = x.astype(jnp.float32)
    y = xf * lax.rsqrt(jnp.mean(xf * xf, axis=-1, keepdims=True) + EPS)
    return (y * g.astype(jnp.float32)).astype(x.dtype)


def _heads(t, n, d):
    b, s, _ = t.shape
    return t.reshape(b, s, n, d).transpose(0, 2, 1, 3)


def _merge(o):
    b, h, s, d = o.shape
    return o.transpose(0, 2, 1, 3).reshape(b, s, h * d)


def _stick_breaking(q, k, v):
    seq, d = q.shape[2], q.shape[3]
    scale = d ** -0.5
    outs = []
    for i in range(seq // Q_BLOCK):
        q0, q1 = i * Q_BLOCK, (i + 1) * Q_BLOCK
        z = jnp.einsum('bhqd,bhkd->bhqk', q[:, :, q0:q1], k[:, :, :q1]).astype(jnp.float32) * scale
        tq = jnp.arange(q0, q1)[:, None]
        sk = jnp.arange(q1)[None, :]
        before = sk < tq
        log_not = jnp.where(before, -jax.nn.softplus(z), 0.0)
        tail = lax.cumsum(log_not, axis=3, reverse=True) - log_not
        w = jnp.where(before, jnp.exp(jax.nn.log_sigmoid(z) + tail), 0.0)
        outs.append(jnp.einsum('bhqk,bhkd->bhqd', w.astype(v.dtype), v[:, :, :q1]))
    return jnp.concatenate(outs, axis=2)


def _diff_attention(q1, q2, k1, k2, v, lam, slopes):
    seq = q1.shape[2]
    scale = DIFF_DIM ** -0.5
    outs = []
    for i in range(seq // Q_BLOCK):
        q0, qe = i * Q_BLOCK, (i + 1) * Q_BLOCK
        tq = jnp.arange(q0, qe)[:, None]
        sk = jnp.arange(qe)[None, :]
        visible = (sk // CHUNK) <= (tq // CHUNK)
        bias = -slopes[:, None, None] * jnp.abs(tq - sk).astype(jnp.float32)

        def probs(qa, ka):
            s = jnp.einsum('bhqd,bhkd->bhqk', qa[:, :, q0:qe], ka[:, :, :qe]).astype(jnp.float32) * scale + bias
            return jax.nn.softmax(jnp.where(visible, s, -jnp.inf), axis=-1)

        a = probs(q1, k1) - lam * probs(q2, k2)
        outs.append(jnp.einsum('bhqk,bhkd->bhqd', a.astype(v.dtype), v[:, :, :qe]))
    return jnp.concatenate(outs, axis=2)


def _forgetting_attention(q, k, v, log_f):
    seq, d = q.shape[2], q.shape[3]
    scale = d ** -0.5
    cum = jnp.cumsum(log_f, axis=-1)
    outs = []
    for i in range(seq // Q_BLOCK):
        q0, q1 = i * Q_BLOCK, (i + 1) * Q_BLOCK
        tq = jnp.arange(q0, q1)[:, None]
        sk = jnp.arange(q1)[None, :]
        s = jnp.einsum('bhqd,bhkd->bhqk', q[:, :, q0:q1], k[:, :, :q1]).astype(jnp.float32) * scale
        s = s + cum[:, :, q0:q1, None] - cum[:, :, None, :q1]
        p = jax.nn.softmax(jnp.where(sk <= tq, s, -jnp.inf), axis=-1)
        outs.append(jnp.einsum('bhqk,bhkd->bhqd', p.astype(v.dtype), v[:, :, :q1]))
    return jnp.concatenate(outs, axis=2)


def setup_inputs(seed: int = 0) -> dict:
    key = jax.random.key(seed)
    ks = jax.random.split(key, 24)
    L, D = DEPTH, D_MODEL

    def w(k, shape, fan_in):
        return jax.random.normal(k, shape, jnp.float32) * fan_in ** -0.5

    def gain(k, shape):
        return 1.0 + 0.02 * jax.random.normal(k, shape, jnp.float32)

    return {
        "x": jax.random.normal(ks[0], (BATCH, SEQ, D), jnp.float32),
        "norm_mix": gain(ks[1], (L, D)),
        "w_in": w(ks[2], (L, D, D_IN), D),
        "b_forget": 3.0 + 0.5 * jax.random.normal(ks[3], (L, H_FOX), jnp.float32),
        "q_norm_diff": gain(ks[4], (L, DIFF_DIM)),
        "k_norm_diff": gain(ks[5], (L, DIFF_DIM)),
        "lambda_q1": 0.1 * jax.random.normal(ks[6], (L, DIFF_DIM), jnp.float32),
        "lambda_k1": 0.1 * jax.random.normal(ks[7], (L, DIFF_DIM), jnp.float32),
        "lambda_q2": 0.1 * jax.random.normal(ks[8], (L, DIFF_DIM), jnp.float32),
        "lambda_k2": 0.1 * jax.random.normal(ks[9], (L, DIFF_DIM), jnp.float32),
        "sub_norm_diff": gain(ks[10], (L, HEAD_DIM)),
        "q_norm_fox": gain(ks[11], (L, HEAD_DIM)),
        "k_norm_fox": gain(ks[12], (L, HEAD_DIM)),
        "w_branch_sb": w(ks[13], (L, D_SB, D), D_SB),
        "w_branch_diff": w(ks[14], (L, D_DIFF, D), D_DIFF),
        "w_branch_fox": w(ks[15], (L, D_FOX, D), D_FOX),
        "w_gate": w(ks[16], (L, D, N_BRANCH * D), D),
        "w_out": w(ks[17], (L, D, D), D),
        "norm_ffn": gain(ks[18], (L, D)),
        "w_ff_gate": w(ks[19], (L, D, D_FF), D),
        "w_ff_up": w(ks[20], (L, D, D_FF), D),
        "w_ff_down": w(ks[21], (L, D_FF, D), D_FF),
    }


def reference(x, norm_mix, w_in, b_forget, q_norm_diff, k_norm_diff, lambda_q1, lambda_k1,
              lambda_q2, lambda_k2, sub_norm_diff, q_norm_fox, k_norm_fox, w_branch_sb,
              w_branch_diff, w_branch_fox, w_gate, w_out, norm_ffn, w_ff_gate, w_ff_up, w_ff_down):
    b, s, d = x.shape
    slopes = 2.0 ** (-ALIBI_MAX * jnp.arange(1, H_DIFF + 1, dtype=jnp.float32) / H_DIFF)
    o1 = 3 * D_SB
    o2 = o1 + 3 * D_DIFF
    o3 = o2 + 3 * D_FOX
    for l in range(DEPTH):
        lambda_init = 0.8 - 0.6 * float(np.exp(-0.3 * l))
        xn = _rms(x, norm_mix[l])
        h = xn @ w_in[l]

        q_a, k_a, v_a = jnp.split(h[..., :o1], 3, axis=-1)
        o_a = _stick_breaking(_heads(q_a, H_SB, HEAD_DIM), _heads(k_a, H_SB, HEAD_DIM),
                              _heads(v_a, H_SB, HEAD_DIM))

        q_b, k_b, v_b = jnp.split(h[..., o1:o2], 3, axis=-1)
        qd = _rms(_heads(q_b, 2 * H_DIFF, DIFF_DIM), q_norm_diff[l]).reshape(b, H_DIFF, 2, s, DIFF_DIM)
        kd = _rms(_heads(k_b, 2 * H_DIFF, DIFF_DIM), k_norm_diff[l]).reshape(b, H_DIFF, 2, s, DIFF_DIM)
        lam = (jnp.exp(jnp.sum(lambda_q1[l].astype(jnp.float32) * lambda_k1[l].astype(jnp.float32)))
               - jnp.exp(jnp.sum(lambda_q2[l].astype(jnp.float32) * lambda_k2[l].astype(jnp.float32)))
               + lambda_init)
        o_b = _diff_attention(qd[:, :, 0], qd[:, :, 1], kd[:, :, 0], kd[:, :, 1],
                              _heads(v_b, H_DIFF, HEAD_DIM), lam, slopes)
        o_b = _rms(o_b, sub_norm_diff[l]) * (1.0 - lambda_init)

        q_c, k_c, v_c = jnp.split(h[..., o2:o3], 3, axis=-1)
        log_f = jax.nn.log_sigmoid(h[..., o3:].astype(jnp.float32)
                                   + b_forget[l].astype(jnp.float32)).transpose(0, 2, 1)
        o_c = _forgetting_attention(_rms(_heads(q_c, H_FOX, HEAD_DIM), q_norm_fox[l]),
                                    _rms(_heads(k_c, H_FOX, HEAD_DIM), k_norm_fox[l]),
                                    _heads(v_c, H_FOX, HEAD_DIM), log_f)

        gates = jax.nn.sigmoid((xn @ w_gate[l]).astype(jnp.float32)).astype(x.dtype).reshape(b, s, N_BRANCH, d)
        y = (gates[:, :, 0] * (_merge(o_a) @ w_branch_sb[l])
             + gates[:, :, 1] * (_merge(o_b) @ w_branch_diff[l])
             + gates[:, :, 2] * (_merge(o_c) @ w_branch_fox[l]))
        x = x + y @ w_out[l]

        xf = _rms(x, norm_ffn[l])
        x = x + (jax.nn.silu(xf @ w_ff_gate[l]) * (xf @ w_ff_up[l])) @ w_ff_down[l]
    return x
```

```cpp
#include <hip/hip_runtime.h>
#include <cstdio>
#include <cstdint>

#ifndef PROBE_REP
#define PROBE_REP (-1)
#endif
#ifndef MK_ONE_LAUNCH
#define MK_ONE_LAUNCH 1
#endif

namespace pg8 {
#define PG8_LAS __attribute__((address_space(3)))
typedef unsigned short bf16_t;
typedef short bf16x8 __attribute__((ext_vector_type(8)));
typedef float f32x4 __attribute__((ext_vector_type(4)));
typedef unsigned u32x4 __attribute__((ext_vector_type(4)));
constexpr int BM = 256, BK = 64, HALF = 128, HTB = HALF * BK * 2, STAGE_BYTES = 8 * HTB, NXCD = 8, WGM = 4;

__host__ __device__ __forceinline__ int lds_byte(int r, int c) { const int st = r >> 3, rr = r & 7, ch = c >> 3, g = (r >> 1) & 7; return st * 1024 + rr * 128 + ((ch ^ g) * 16) + (c & 7) * 2; }
__host__ __device__ __forceinline__ void stage_rc(int b, int& R, int& C) { const int st = b / 1024, sb = b % 1024, rr = sb / 128, pch = (sb % 128) / 16; R = st * 8 + rr; C = (pch ^ ((R >> 1) & 7)) * 8; }
__host__ __device__ __forceinline__ int perm32(int rho) { const int n = rho >> 4, i = rho & 15; return 8 * (i >> 2) + 4 * n + (i & 3); }

struct Unit { int pm, pn, br; };
struct Gemm { const bf16_t* A; const bf16_t* Bt; int M, N, K, lda, ldb;
              int a_off1, a_off2, b_stride, k_dec;
              const bf16_t* A_alt; const bf16_t* B_alt; int b_stride_alt, K_alt; };
__device__ __forceinline__ Gemm mk_gemm(const bf16_t* A, const bf16_t* Bt, int M, int N, int K, int lda, int ldb) { Gemm g; g.A = A; g.Bt = Bt; g.M = M; g.N = N; g.K = K; g.lda = lda; g.ldb = ldb; g.a_off1 = 0; g.a_off2 = 0; g.b_stride = 0; g.k_dec = 0; g.A_alt = A; g.B_alt = Bt; g.b_stride_alt = 0; g.K_alt = K; return g; }
template <bool SIX> __device__ __forceinline__ const char* gemm_a(const Gemm& g, int br) { if (SIX) { const int i = br >> 1; return (const char*)((br & 1) ? g.A_alt + (size_t)((i > 0) * g.a_off1 + (i > 1) * g.a_off2) : g.A); } return (const char*)(g.A + (size_t)((br > 0) * g.a_off1 + (br > 1) * g.a_off2)); }
template <bool SIX> __device__ __forceinline__ const char* gemm_b(const Gemm& g, int br) { if (SIX) { const int i = br >> 1; return (const char*)((br & 1) ? g.B_alt + (size_t)i * g.b_stride_alt : g.Bt + (size_t)i * g.b_stride); } return (const char*)(g.Bt + (size_t)br * g.b_stride); }
template <bool SIX> __device__ __forceinline__ int gemm_k(const Gemm& g, int br) { if (SIX) { const int i = br >> 1; return (br & 1) ? g.K_alt - (i > 0) * g.k_dec : g.K; } return g.K - (br > 0) * g.k_dec; }

struct StaticOrder {
    static constexpr bool SIX = false;
    int nM, nN, nwg, G, c;
    __host__ __device__ void init(int M, int N, int G_, int c_) { nM = M / BM; nN = N / BM; nwg = nM * nN; G = G_; c = c_; }
    __host__ __device__ __forceinline__ bool next(int i, Unit& u) const {
        const long L = (long)i * G + c; if (L >= nwg) return false;
        int wgid = (int)L; { const int q = nwg / NXCD, r = nwg % NXCD, xcd = wgid % NXCD, off = wgid / NXCD; wgid = (xcd < r ? xcd * (q + 1) : r * (q + 1) + (xcd - r) * q) + off; }
        const int nig = WGM * nN, gid = wgid / nig, fm = gid * WGM, gsz = (nM - fm) < WGM ? (nM - fm) : WGM;
        u.pm = fm + ((wgid % nig) % gsz); u.pn = (wgid % nig) / gsz; u.br = 0; return true;
    }
    __device__ __forceinline__ void a_ready(const Unit&) const {}
    __device__ __forceinline__ void done(const Unit&) const {}
};

struct SixOrder {
    static constexpr bool SIX = true;
    StaticOrder S;
    __device__ __forceinline__ bool next(int ui, Unit& u) const { const int i = ui / 6, br = ui - 6 * i; const bool ok = S.next(i, u); u.br = br; return ok; }
    __device__ __forceinline__ void a_ready(const Unit&) const {}
    __device__ __forceinline__ void done(const Unit&) const {}
};

__device__ __forceinline__ unsigned cvt_pk_bf16(float lo, float hi) { unsigned r; asm volatile("v_cvt_pk_bf16_f32 %0, %1, %2" : "=v"(r) : "v"(lo), "v"(hi)); return r; }
__device__ __forceinline__ float bflo(unsigned w) { return __uint_as_float(w << 16); }
__device__ __forceinline__ float bfhi(unsigned w) { return __uint_as_float(w & 0xffff0000u); }
__device__ __forceinline__ float sigmoidf_fast(float x) { return __builtin_amdgcn_rcpf(1.0f + __builtin_amdgcn_exp2f(-1.4426950408889634f * x)); }
typedef float f32x2 __attribute__((ext_vector_type(2)));
constexpr float NLOG2E = -1.4426950408889634f;
__device__ __forceinline__ f32x2 sig2_scaled(f32x2 x, float k) {
    const f32x2 t = x * k; const f32x2 e = {__builtin_amdgcn_exp2f(t.x), __builtin_amdgcn_exp2f(t.y)}; const f32x2 d = e + 1.0f;
    return (f32x2){__builtin_amdgcn_rcpf(d.x), __builtin_amdgcn_rcpf(d.y)}; }


__device__ __forceinline__ void rstd_to_lds(const float* rstd, int pm, int wid, int lane, PG8_LAS float* dst, int k) {
    if (wid < 4) __builtin_amdgcn_global_load_lds((const unsigned*)(rstd + (size_t)pm * BM + wid * 64 + lane), (PG8_LAS unsigned*)(dst + k * BM + wid * 64), 4, 0, 0);
}
__device__ __forceinline__ u32x4 lanes_to_rows(u32x4 w, int lane) { const int a = ((lane & 3) * 16 + (lane >> 2)) * 4;
    w.x = (unsigned)__builtin_amdgcn_ds_bpermute(a, (int)w.x); w.y = (unsigned)__builtin_amdgcn_ds_bpermute(a, (int)w.y); w.z = (unsigned)__builtin_amdgcn_ds_bpermute(a, (int)w.z); w.w = (unsigned)__builtin_amdgcn_ds_bpermute(a, (int)w.w); return w; }
__device__ __forceinline__ u32x4 rows_to_lanes(u32x4 w, int lane) { const int a = ((lane & 15) * 4 + (lane >> 4)) * 4;
    w.x = (unsigned)__builtin_amdgcn_ds_bpermute(a, (int)w.x); w.y = (unsigned)__builtin_amdgcn_ds_bpermute(a, (int)w.y); w.z = (unsigned)__builtin_amdgcn_ds_bpermute(a, (int)w.z); w.w = (unsigned)__builtin_amdgcn_ds_bpermute(a, (int)w.w); return w; }
struct EpiInProj {
    static constexpr bool PERM = true, AFTER_DRAIN = false, HAS_STATE = true, HAS_PRE = true;
    struct State { int k; };
    bf16_t* H; int ld; size_t sstride; PG8_LAS float* scr;
    const float* rstd; PG8_LAS float* rl;
    __device__ __forceinline__ void pre(const Unit& u, int wr, int wc, int fr, int fq, State& st) const { st.k ^= 1; rstd_to_lds(rstd, u.pm, wr * 4 + wc, fq * 16 + fr, rl, st.k); }
    __device__ __forceinline__ void operator()(const f32x4 (&acc)[2][2][4][2], const Unit& u, int wr, int wc, int fr, int fq, State& st) const {
        const int row0 = u.pm * BM + wr * 64 + fr; const int colt = u.pn * BM;
        const PG8_LAS float* rp = rl + st.k * BM + wr * 64 + fr;
        const int col0 = colt + wc * 32 + 8 * fq;
        const int h0 = 2 * u.pn, h1 = h0 + 1;
        const int md0 = (h0 >= 23 && h0 <= 27) ? 1 : ((h0 >= 38 && h0 <= 42) ? 2 : 0), md1 = (h1 >= 23 && h1 <= 27) ? 1 : ((h1 >= 38 && h1 <= 42) ? 2 : 0);
        if (md0 | md1) {
#pragma unroll
            for (int ai = 0; ai < 2; ++ai)
#pragma unroll
                for (int m = 0; m < 4; ++m)
#pragma unroll
                    for (int bj = 0; bj < 2; ++bj) { const f32x4 v0 = acc[ai][bj][m][0], v1 = acc[ai][bj][m][1];
                        float ss = ((v0[0] * v0[0] + v0[1] * v0[1]) + (v0[2] * v0[2] + v0[3] * v0[3])) + ((v1[0] * v1[0] + v1[1] * v1[1]) + (v1[2] * v1[2] + v1[3] * v1[3]));
                        ss += __builtin_bit_cast(float, __builtin_amdgcn_ds_swizzle(__builtin_bit_cast(int, ss), 0x401F));
                        { auto rr = __builtin_amdgcn_permlane32_swap(__float_as_uint(ss), __float_as_uint(ss), false, false); ss = __uint_as_float(rr[0]) + __uint_as_float(rr[1]); }
                        if (fq == 0) scr[((wr * 64 + ai * HALF + m * 16 + fr) * 2 + bj) * 4 + wc] = ss; }
            asm volatile("s_waitcnt lgkmcnt(0)" ::: "memory"); __builtin_amdgcn_s_barrier(); asm volatile("" ::: "memory");
        }
        const int lane_ = fq * 16 + fr;
        bf16_t* const HT = H + (size_t)(2 * u.pn) * sstride + (size_t)(u.pm * BM + wr * 64 + (lane_ >> 2)) * ld + wc * 32 + 8 * (lane_ & 3);
#pragma unroll
        for (int ai = 0; ai < 2; ++ai)
#pragma unroll
            for (int m = 0; m < 4; ++m) { bf16_t* rowp = HT + (size_t)(ai * HALF + m * 16) * ld;
                const float rs = rp[ai * HALF + m * 16];
#pragma unroll
                for (int bj = 0; bj < 2; ++bj) { const int md = bj ? md1 : md0; float sc = rs;
                    if (md) { const f32x4 p = *(const PG8_LAS f32x4*)(scr + ((wr * 64 + ai * HALF + m * 16 + fr) * 2 + bj) * 4);
                        const float s64 = ((wc < 2) ? (p[0] + p[1]) : (p[2] + p[3])) * (rs * rs), s128 = ((p[0] + p[1]) + (p[2] + p[3])) * (rs * rs);
                        sc = rs * (md == 1 ? __builtin_amdgcn_rsqf(s64 * (1.f / 64.f) + 1e-6f) : __builtin_amdgcn_rsqf(s128 * (1.f / 128.f) + 1e-6f)); }
                    const f32x4 v0 = acc[ai][bj][m][0] * sc, v1 = acc[ai][bj][m][1] * sc;
                    u32x4 w; w.x = cvt_pk_bf16(v0[0], v0[1]); w.y = cvt_pk_bf16(v0[2], v0[3]); w.z = cvt_pk_bf16(v1[0], v1[1]); w.w = cvt_pk_bf16(v1[2], v1[3]);
                    *(u32x4*)(rowp + bj * sstride) = lanes_to_rows(w, lane_); } }
    }
};
struct EpiGateBranch {
    static constexpr bool PERM = true, AFTER_DRAIN = false, HAS_STATE = true, HAS_PRE = true;
    struct State { unsigned q[16]; int k; };
    bf16_t* GS; bf16_t* Y; int ldy;
    const float* rstd; PG8_LAS float* rl;
    __device__ __forceinline__ void pre(const Unit& u, int wr, int wc, int fr, int fq, State& st) const { st.k ^= 1; rstd_to_lds(rstd, u.pm, wr * 4 + wc, fq * 16 + fr, rl, st.k); }
    __device__ __forceinline__ void operator()(const f32x4 (&acc)[2][2][4][2], const Unit& u, int wr, int wc, int fr_, int fq, State& st) const {
        int fr = fr_; asm volatile("" : "+v"(fr));
        u32x4* gs = (u32x4*)GS + (((wr * 4 + wc) * 64) + fq * 16 + fr);
        if ((u.br & 1) == 0) {
#pragma unroll
            for (int ai = 0; ai < 2; ++ai) {
                unsigned q[16];
#pragma unroll
                for (int m = 0; m < 4; ++m) { const float rs = rl[st.k * BM + wr * 64 + ai * HALF + m * 16 + fr];
#pragma unroll
                    for (int bj = 0; bj < 2; ++bj) { const f32x4 v0 = acc[ai][bj][m][0], v1 = acc[ai][bj][m][1]; const float k = rs * NLOG2E;
                        unsigned b[8];
                        { const f32x2 s0 = sig2_scaled(v0.lo, k) * 255.f + 0.5f, s1 = sig2_scaled(v0.hi, k) * 255.f + 0.5f, s2 = sig2_scaled(v1.lo, k) * 255.f + 0.5f, s3 = sig2_scaled(v1.hi, k) * 255.f + 0.5f;
                          b[0] = (unsigned)s0.x; b[1] = (unsigned)s0.y; b[2] = (unsigned)s1.x; b[3] = (unsigned)s1.y; b[4] = (unsigned)s2.x; b[5] = (unsigned)s2.y; b[6] = (unsigned)s3.x; b[7] = (unsigned)s3.y; }
                        q[(m * 2 + bj) * 2 + 0] = (b[0] | (b[1] << 8)) | ((b[2] << 16) | (b[3] << 24));
                        q[(m * 2 + bj) * 2 + 1] = (b[4] | (b[5] << 8)) | ((b[6] << 16) | (b[7] << 24)); } }
                if (ai == 0) {
#pragma unroll
                    for (int i = 0; i < 16; ++i) st.q[i] = q[i];
                } else {
#pragma unroll
                    for (int p = 0; p < 4; ++p) gs[p * 512] = (u32x4){q[4 * p], q[4 * p + 1], q[4 * p + 2], q[4 * p + 3]};
                }
            }
        } else {
            const int lane_ = fq * 16 + fr;
            const int row0 = u.pm * BM + wr * 64 + (lane_ >> 2); const int col0 = u.pn * BM + wc * 32 + 8 * (lane_ & 3);
            const bool first = u.br == 1;
            constexpr float Q = 1.f / 255.f;
#pragma unroll
            for (int ai = 0; ai < 2; ++ai) {
                u32x4 y[4][2]; unsigned q[16];
                if (ai == 0) {
#pragma unroll
                    for (int i = 0; i < 16; ++i) q[i] = st.q[i];
                } else {
#pragma unroll
                    for (int p = 0; p < 4; ++p) { const u32x4 t = gs[p * 512]; q[4 * p] = t.x; q[4 * p + 1] = t.y; q[4 * p + 2] = t.z; q[4 * p + 3] = t.w; }
                }
#pragma unroll
                for (int m = 0; m < 4; ++m)
#pragma unroll
                    for (int bj = 0; bj < 2; ++bj) { const size_t r = (size_t)(row0 + ai * HALF + m * 16);
                        if (!first) y[m][bj] = *(const u32x4*)(Y + r * ldy + col0 + bj * HALF); else y[m][bj] = (u32x4){0u, 0u, 0u, 0u}; }
                if (!first) {
#pragma unroll
                    for (int m = 0; m < 4; ++m)
#pragma unroll
                        for (int bj = 0; bj < 2; ++bj) y[m][bj] = rows_to_lanes(y[m][bj], lane_); }
#pragma unroll
                for (int m = 0; m < 4; ++m)
#pragma unroll
                    for (int bj = 0; bj < 2; ++bj) { const size_t r = (size_t)(row0 + ai * HALF + m * 16); const f32x4 v0 = acc[ai][bj][m][0], v1 = acc[ai][bj][m][1]; const u32x4 yy = y[m][bj];
                        const unsigned q0 = q[(m * 2 + bj) * 2 + 0], q1 = q[(m * 2 + bj) * 2 + 1];
                        float o[8];
                        o[0] = ((float)(q0 & 255u) * v0[0]) * Q + bflo(yy.x); o[1] = ((float)((q0 >> 8) & 255u) * v0[1]) * Q + bfhi(yy.x); o[2] = ((float)((q0 >> 16) & 255u) * v0[2]) * Q + bflo(yy.y); o[3] = ((float)(q0 >> 24) * v0[3]) * Q + bfhi(yy.y);
                        o[4] = ((float)(q1 & 255u) * v1[0]) * Q + bflo(yy.z); o[5] = ((float)((q1 >> 8) & 255u) * v1[1]) * Q + bfhi(yy.z); o[6] = ((float)((q1 >> 16) & 255u) * v1[2]) * Q + bflo(yy.w); o[7] = ((float)(q1 >> 24) * v1[3]) * Q + bfhi(yy.w);
                        u32x4 w; w.x = cvt_pk_bf16(o[0], o[1]); w.y = cvt_pk_bf16(o[2], o[3]); w.z = cvt_pk_bf16(o[4], o[5]); w.w = cvt_pk_bf16(o[6], o[7]);
                        *(u32x4*)(Y + r * ldy + col0 + bj * HALF) = lanes_to_rows(w, lane_); }
            }
        }
    }
};
struct EpiResid {
    static constexpr bool PERM = true, AFTER_DRAIN = false, HAS_STATE = false, HAS_PRE = false;
    struct State {};
    const bf16_t* base; bf16_t* outb; float* outf; int ldc; float* ssq; PG8_LAS float* scr;
    __device__ __forceinline__ void operator()(const f32x4 (&acc)[2][2][4][2], const Unit& u, int wr, int wc, int fr, int fq) const {
        const int lane_ = fq * 16 + fr;
        const int row0T = u.pm * BM + wr * 64 + (lane_ >> 2); const int col0T = u.pn * BM + wc * 32 + 8 * (lane_ & 3);
        float ss[2][4];
#pragma unroll
        for (int ai = 0; ai < 2; ++ai) {
            u32x4 b[4][2];
#pragma unroll
            for (int m = 0; m < 4; ++m) { const size_t offT = (size_t)(row0T + ai * HALF + m * 16) * ldc + col0T;
#pragma unroll
                for (int bj = 0; bj < 2; ++bj) b[m][bj] = *(const u32x4*)(base + offT + bj * HALF); }
#pragma unroll
            for (int m = 0; m < 4; ++m)
#pragma unroll
                for (int bj = 0; bj < 2; ++bj) b[m][bj] = rows_to_lanes(b[m][bj], lane_);
#pragma unroll
            for (int m = 0; m < 4; ++m) { const size_t offT = (size_t)(row0T + ai * HALF + m * 16) * ldc + col0T; float sq = 0.f;
#pragma unroll
                for (int bj = 0; bj < 2; ++bj) { const u32x4 bb = b[m][bj]; const f32x4 v0 = acc[ai][bj][m][0], v1 = acc[ai][bj][m][1];
                    const f32x4 o0 = {bflo(bb.x) + v0[0], bfhi(bb.x) + v0[1], bflo(bb.y) + v0[2], bfhi(bb.y) + v0[3]}, o1 = {bflo(bb.z) + v1[0], bfhi(bb.z) + v1[1], bflo(bb.w) + v1[2], bfhi(bb.w) + v1[3]};
                    sq += ((o0[0] * o0[0] + o0[1] * o0[1]) + (o0[2] * o0[2] + o0[3] * o0[3])) + ((o1[0] * o1[0] + o1[1] * o1[1]) + (o1[2] * o1[2] + o1[3] * o1[3]));
                    if (outf) { const u32x4 t0 = lanes_to_rows(__builtin_bit_cast(u32x4, o0), lane_), t1 = lanes_to_rows(__builtin_bit_cast(u32x4, o1), lane_);
                        *(u32x4*)(outf + offT + bj * HALF) = t0; *(u32x4*)(outf + offT + bj * HALF + 4) = t1; }
                    else { u32x4 w; w.x = cvt_pk_bf16(o0[0], o0[1]); w.y = cvt_pk_bf16(o0[2], o0[3]); w.z = cvt_pk_bf16(o1[0], o1[1]); w.w = cvt_pk_bf16(o1[2], o1[3]); *(u32x4*)(outb + offT + bj * HALF) = lanes_to_rows(w, lane_); } }
                ss[ai][m] = sq; }
        }
        if (ssq) {
#pragma unroll
            for (int ai = 0; ai < 2; ++ai)
#pragma unroll
                for (int m = 0; m < 4; ++m) { float t = ss[ai][m];
                    t += __builtin_bit_cast(float, __builtin_amdgcn_ds_swizzle(__builtin_bit_cast(int, t), 0x401F));
                    { auto rr = __builtin_amdgcn_permlane32_swap(__float_as_uint(t), __float_as_uint(t), false, false); t = __uint_as_float(rr[0]) + __uint_as_float(rr[1]); }
                    if (fq == 0) scr[(wr * 64 + ai * HALF + m * 16 + fr) * 4 + wc] = t; }
            asm volatile("s_waitcnt lgkmcnt(0)" ::: "memory"); __builtin_amdgcn_s_barrier(); asm volatile("" ::: "memory");
            const int t_ = (wr * 4 + wc) * 64 + fq * 16 + fr;
            if (t_ < BM) { const f32x4 p = *(const PG8_LAS f32x4*)(scr + t_ * 4); ssq[(size_t)(u.pm * BM + t_) * 8 + u.pn] = (p[0] + p[1]) + (p[2] + p[3]); }
        }
    }
};
struct EpiSwiglu {
    static constexpr bool PERM = true, AFTER_DRAIN = false, HAS_STATE = true, HAS_PRE = true;
    struct State { f32x4 p0, p1; };
    bf16_t* O; int ldo; const float* ssq; PG8_LAS float* scr; float inv_n, eps;
    __device__ __forceinline__ void pre(const Unit& u, int wr, int wc, int fr, int fq, State& st) const {
        const int t_ = ((wr * 4 + wc) * 64 + fq * 16 + fr) & (BM - 1);
        const f32x4* p = (const f32x4*)(ssq + (size_t)(u.pm * BM + t_) * 8); st.p0 = p[0]; st.p1 = p[1];
    }
    __device__ __forceinline__ void operator()(const f32x4 (&acc)[2][2][4][2], const Unit& u, int wr, int wc, int fr, int fq, State& st) const {
        { const int t_ = (wr * 4 + wc) * 64 + fq * 16 + fr;
          const float sum = ((st.p0[0] + st.p0[1]) + (st.p0[2] + st.p0[3])) + ((st.p1[0] + st.p1[1]) + (st.p1[2] + st.p1[3]));
          if (t_ < BM) scr[t_] = __builtin_amdgcn_rsqf(sum * inv_n + eps);
          asm volatile("s_waitcnt lgkmcnt(0)" ::: "memory"); __builtin_amdgcn_s_barrier(); asm volatile("" ::: "memory"); }
        const int lane_ = fq * 16 + fr;
        const int row0 = u.pm * BM + wr * 64 + (lane_ >> 2); const int col0 = u.pn * HALF + wc * 32 + 8 * (lane_ & 3);
#pragma unroll
        for (int ai = 0; ai < 2; ++ai)
#pragma unroll
            for (int m = 0; m < 4; ++m) { bf16_t* rowp = O + (size_t)(row0 + ai * HALF + m * 16) * ldo + col0;
                const float rs = scr[wr * 64 + ai * HALF + m * 16 + fr];
                const float k = rs * NLOG2E, rs2 = rs * rs;
                const f32x4 g0 = acc[ai][0][m][0], g1 = acc[ai][0][m][1], u0 = acc[ai][1][m][0], u1 = acc[ai][1][m][1];
                const f32x2 o0 = (g0.lo * u0.lo) * (sig2_scaled(g0.lo, k) * rs2), o1 = (g0.hi * u0.hi) * (sig2_scaled(g0.hi, k) * rs2), o2 = (g1.lo * u1.lo) * (sig2_scaled(g1.lo, k) * rs2), o3 = (g1.hi * u1.hi) * (sig2_scaled(g1.hi, k) * rs2);
                u32x4 w; w.x = cvt_pk_bf16(o0.x, o0.y); w.y = cvt_pk_bf16(o1.x, o1.y); w.z = cvt_pk_bf16(o2.x, o2.y); w.w = cvt_pk_bf16(o3.x, o3.y);
                *(u32x4*)rowp = lanes_to_rows(w, lane_); }
    }
};

template <class Epi, class Sched, bool ALIGN_EPI = false, bool SP2 = false>
__device__ __forceinline__ void gemm_phase(PG8_LAS unsigned char* lds, const Gemm g, const Sched& S, const Epi& E) {
    int tid_ = threadIdx.x; asm volatile("" : "+v"(tid_));
    const int tid = tid_, wid = __builtin_amdgcn_readfirstlane(tid >> 6), lane = tid & 63, wr = wid >> 2, wc = wid & 3, fr = lane & 15, fq = lane >> 4;
    unsigned voffA[2], voffB[2];
#pragma unroll
    for (int i = 0; i < 2; ++i) { int R, C; stage_rc(tid * 16 + i * 8192, R, C); const int Rb = Epi::PERM ? ((R & ~31) + perm32(R & 31)) : R;
        voffA[i] = (unsigned)(R * g.lda + C) * 2u; voffB[i] = (unsigned)(Rb * g.ldb + C) * 2u; }
    const size_t kstep = (size_t)(BK * 2);
    const size_t hstepA = (size_t)HALF * g.lda * 2, hstepB = (size_t)HALF * g.ldb * 2;
    const size_t tstepA = 2 * hstepA, tstepB = 2 * hstepB;
    const unsigned ldsw = (unsigned)wid * 1024u;
    const int aoff = lds_byte(wr * 64 + fr, fq * 8), boff = lds_byte(wc * 32 + fr, fq * 8);
#define PG8_SA(b, h) (((b) * 2 + (h)) * HTB)
#define PG8_SB(b, h) ((4 + (b) * 2 + (h)) * HTB)
#define PG8_STAGE(bufoff, gbase, voff) do { _Pragma("unroll") for (int _i = 0; _i < 2; ++_i) \
        __builtin_amdgcn_global_load_lds((const unsigned*)((const char*)(gbase) + (voff)[_i]), (PG8_LAS unsigned*)(lds + (bufoff) + ldsw + _i * 8192), 16, 0, 0); } while (0)
#define PG8_LDA(dst, b, h) do { _Pragma("unroll") for (int m = 0; m < 4; ++m) _Pragma("unroll") for (int k = 0; k < 2; ++k) dst[m][k] = *(const PG8_LAS bf16x8*)(lds + PG8_SA(b, h) + (aoff ^ (k * 64)) + m * 2048); } while (0)
#define PG8_LDB(dst, b, h) do { _Pragma("unroll") for (int n = 0; n < 2; ++n) _Pragma("unroll") for (int k = 0; k < 2; ++k) dst[n][k] = *(const PG8_LAS bf16x8*)(lds + PG8_SB(b, h) + (boff ^ (k * 64)) + n * 2048); } while (0)
#define PG8_MMA(ai, bj, At, Bt) do { __builtin_amdgcn_s_setprio(1); _Pragma("unroll") for (int m = 0; m < 4; ++m) _Pragma("unroll") for (int n = 0; n < 2; ++n) _Pragma("unroll") for (int k = 0; k < 2; ++k) \
        acc[ai][bj][m][n] = __builtin_amdgcn_mfma_f32_16x16x32_bf16(Bt[n][k], At[m][k], acc[ai][bj][m][n], 0, 0, 0); __builtin_amdgcn_s_setprio(0); } while (0)
#define PG8_WAIT_V(n) asm volatile("s_waitcnt vmcnt(" #n ")" ::: "memory")
#define PG8_WAIT_L(n) asm volatile("s_waitcnt lgkmcnt(" #n ")" ::: "memory")
#define PG8_BAR __builtin_amdgcn_s_barrier()
#define PG8_SCHED __builtin_amdgcn_sched_barrier(0)
    Unit cur, nxt; int ui = 0;
    if (!S.next(0, cur)) return;
    f32x4 acc[2][2][4][2];
#pragma unroll
    for (int a = 0; a < 2; ++a)
#pragma unroll
        for (int b = 0; b < 2; ++b)
#pragma unroll
            for (int m = 0; m < 4; ++m)
#pragma unroll
                for (int n = 0; n < 2; ++n) acc[a][b][m][n] = (f32x4){0.f, 0.f, 0.f, 0.f};
    bf16x8 At[4][2], B0[2][2], B1[2][2];
    typename Epi::State est{};
    const char* cA = gemm_a<Sched::SIX>(g, cur.br) + (size_t)cur.pm * tstepA; const char* cB = gemm_b<Sched::SIX>(g, cur.br) + (size_t)cur.pn * tstepB;
    S.a_ready(cur);
    if constexpr (SP2) {
        PG8_STAGE(PG8_SB(0, 0), cB, voffB); PG8_STAGE(PG8_SB(0, 1), cB + hstepB, voffB); PG8_STAGE(PG8_SA(0, 0), cA, voffA); PG8_STAGE(PG8_SA(0, 1), cA + hstepA, voffA);
        if (wr == 1) PG8_BAR;
        PG8_WAIT_V(2); PG8_BAR;
        PG8_STAGE(PG8_SB(1, 0), cB + kstep, voffB); PG8_STAGE(PG8_SA(1, 0), cA + kstep, voffA); PG8_STAGE(PG8_SB(1, 1), cB + hstepB + kstep, voffB);
        PG8_WAIT_V(6); PG8_BAR;
    } else {
        PG8_STAGE(PG8_SB(0, 0), cB, voffB); PG8_STAGE(PG8_SA(0, 0), cA, voffA); PG8_STAGE(PG8_SB(0, 1), cB + hstepB, voffB); PG8_STAGE(PG8_SA(0, 1), cA + hstepA, voffA);
        if (wr == 1) PG8_BAR;
        PG8_WAIT_V(4); PG8_BAR;
        PG8_STAGE(PG8_SB(1, 0), cB + kstep, voffB); PG8_STAGE(PG8_SA(1, 0), cA + kstep, voffA); PG8_STAGE(PG8_SB(1, 1), cB + hstepB + kstep, voffB);
        PG8_WAIT_V(6); PG8_BAR;
    }
    for (;;) {
        const bool has_next = S.next(ui + 1, nxt);
        const char* nA = has_next ? gemm_a<Sched::SIX>(g, nxt.br) + (size_t)nxt.pm * tstepA : cA; const char* nB = has_next ? gemm_b<Sched::SIX>(g, nxt.br) + (size_t)nxt.pn * tstepB : cB;
        const int nt = gemm_k<Sched::SIX>(g, cur.br) / BK;
        if constexpr (Epi::HAS_PRE) { int t2 = threadIdx.x; asm volatile("" : "+v"(t2)); E.pre(cur, wr, wc, t2 & 15, (t2 >> 4) & 3, est); }
        for (int t = 0; t < nt; t += 2) {
            const bool last = (t == nt - 2);
            const char* a1 = cA + (size_t)(t + 1) * kstep;
            const char* a2 = last ? nA : cA + (size_t)(t + 2) * kstep; const char* b2 = last ? nB : cB + (size_t)(t + 2) * kstep;
            const char* a3 = a2 + kstep; const char* b3 = b2 + kstep;
            if (last && has_next) S.a_ready(nxt);
            if constexpr (SP2) {
            PG8_LDB(B0, 0, 0); PG8_LDB(B1, 0, 1); PG8_SCHED; PG8_LDA(At, 0, 0); PG8_STAGE(PG8_SA(1, 1), a1 + hstepA, voffA);
            PG8_WAIT_V(8); PG8_WAIT_L(0); PG8_BAR; PG8_MMA(0, 0, At, B0); PG8_MMA(0, 1, At, B1); PG8_BAR; PG8_SCHED;
            PG8_LDA(At, 0, 1); PG8_STAGE(PG8_SB(0, 0), b2, voffB); PG8_STAGE(PG8_SB(0, 1), b2 + hstepB, voffB); PG8_STAGE(PG8_SA(0, 0), a2, voffA);
            PG8_WAIT_V(8); PG8_WAIT_L(0); PG8_BAR; PG8_MMA(1, 0, At, B0); PG8_MMA(1, 1, At, B1); PG8_BAR; PG8_SCHED;
            PG8_LDB(B0, 1, 0); PG8_LDB(B1, 1, 1); PG8_SCHED; PG8_LDA(At, 1, 0); PG8_STAGE(PG8_SA(0, 1), a2 + hstepA, voffA);
            PG8_WAIT_V(8); PG8_WAIT_L(0); PG8_BAR; PG8_MMA(0, 0, At, B0); PG8_MMA(0, 1, At, B1); PG8_BAR; PG8_SCHED;
            PG8_LDA(At, 1, 1); PG8_STAGE(PG8_SB(1, 0), b3, voffB); PG8_STAGE(PG8_SB(1, 1), b3 + hstepB, voffB); PG8_STAGE(PG8_SA(1, 0), a3, voffA);
            PG8_WAIT_V(8); PG8_WAIT_L(0); PG8_BAR; PG8_MMA(1, 0, At, B0); PG8_MMA(1, 1, At, B1); PG8_BAR; PG8_SCHED;
            } else {
            PG8_LDB(B0, 0, 0); PG8_SCHED; PG8_LDA(At, 0, 0); PG8_STAGE(PG8_SA(1, 1), a1 + hstepA, voffA);
            PG8_WAIT_L(8); PG8_BAR; PG8_WAIT_L(0); PG8_MMA(0, 0, At, B0); PG8_BAR; PG8_SCHED;
            PG8_LDB(B1, 0, 1); PG8_STAGE(PG8_SB(0, 0), b2, voffB);
            PG8_BAR; PG8_WAIT_L(0); PG8_MMA(0, 1, At, B1); PG8_BAR;
            PG8_LDA(At, 0, 1); PG8_STAGE(PG8_SA(0, 0), a2, voffA);
            PG8_BAR; PG8_WAIT_L(0); PG8_MMA(1, 0, At, B0); PG8_BAR; PG8_SCHED;
            PG8_STAGE(PG8_SB(0, 1), b2 + hstepB, voffB);
            PG8_WAIT_V(6); PG8_BAR; PG8_MMA(1, 1, At, B1); PG8_BAR;
            PG8_LDB(B0, 1, 0); PG8_SCHED; PG8_LDA(At, 1, 0); PG8_STAGE(PG8_SA(0, 1), a2 + hstepA, voffA);
            PG8_WAIT_L(8); PG8_BAR; PG8_WAIT_L(0); PG8_MMA(0, 0, At, B0); PG8_BAR; PG8_SCHED;
            PG8_LDB(B1, 1, 1); PG8_STAGE(PG8_SB(1, 0), b3, voffB);
            PG8_BAR; PG8_WAIT_L(0); PG8_MMA(0, 1, At, B1); PG8_BAR;
            PG8_LDA(At, 1, 1); PG8_STAGE(PG8_SA(1, 0), a3, voffA);
            PG8_BAR; PG8_WAIT_L(0); PG8_MMA(1, 0, At, B0); PG8_BAR; PG8_SCHED;
            PG8_STAGE(PG8_SB(1, 1), b3 + hstepB, voffB);
            PG8_WAIT_V(6); PG8_BAR; PG8_MMA(1, 1, At, B1); PG8_BAR;
            }
        }
        if constexpr (ALIGN_EPI) { if (wr == 0) PG8_BAR; }
        { int t2 = threadIdx.x; asm volatile("" : "+v"(t2)); const int fr2 = t2 & 15, fq2 = (t2 >> 4) & 3;
          if constexpr (Epi::HAS_STATE) { E(acc, cur, wr, wc, fr2, fq2, est); S.done(cur); } else if constexpr (!Epi::AFTER_DRAIN) { E(acc, cur, wr, wc, fr2, fq2); S.done(cur); } }
        if (!has_next) break;
#pragma unroll
        for (int a = 0; a < 2; ++a)
#pragma unroll
            for (int b = 0; b < 2; ++b)
#pragma unroll
                for (int m = 0; m < 4; ++m)
#pragma unroll
                    for (int n = 0; n < 2; ++n) acc[a][b][m][n] = (f32x4){0.f, 0.f, 0.f, 0.f};
        cur = nxt; cA = nA; cB = nB; ++ui;
        if constexpr (ALIGN_EPI) { if (wr == 1) PG8_BAR; }
    }
    PG8_WAIT_V(0);
    if constexpr (!ALIGN_EPI) { if (wr == 0) PG8_BAR; }
    PG8_BAR;
#undef PG8_SA
#undef PG8_SB
#undef PG8_STAGE
#undef PG8_LDA
#undef PG8_LDB
#undef PG8_MMA
#undef PG8_WAIT_V
#undef PG8_WAIT_L
#undef PG8_BAR
#undef PG8_SCHED
}
}

constexpr int NWAVES = 8;
constexpr int BATCH = 16, SEQ = 2048, DM = 2048, DEPTH = 4;
constexpr int M = BATCH * SEQ;
constexpr int HD = 128, H_SB = 6, H_DIFF = 5, H_FOX = 5;
constexpr int D_SB = 768, D_DIFF = 640, D_FOX = 640;
constexpr int D_QKV = 6144, D_IN = 6149, D_FF = 5632;
constexpr int NGU = 2 * D_FF;
constexpr int QA = 0, KA = 768, VA = 1536, QB_ = 2304, KB_ = 2944, VB_ = 3584, QC = 4224, KC = 4864, VC = 5504;
constexpr int OA = 0, OB = 768, OC = 1408;
constexpr int HLD = 128;
__host__ __device__ constexpr size_t hslot(int col) { return (size_t)(col / 128) * ((size_t)BATCH * SEQ * 128); }
constexpr float EPS = 1e-6f;
constexpr int NPH = 8;
constexpr int NSTEP = DEPTH * NPH;

constexpr size_t MiB = 1u << 20;
constexpr size_t WS_CTL = 0, CTL_ZERO_BYTES = 2 * MiB;
constexpr size_t WS_WIG = 2 * MiB;
constexpr size_t WS_WBR = WS_WIG + 48 * MiB;
constexpr size_t WS_WOUT = WS_WBR + 24 * MiB;
constexpr size_t WS_WGU = WS_WOUT + 8 * MiB;
constexpr size_t WS_WDN = WS_WGU + 44 * MiB;
constexpr size_t WS_LOGF = WS_WDN + 22 * MiB;
constexpr size_t WS_CUM = WS_LOGF + 1 * MiB;
constexpr size_t WS_XN = WS_CUM + 1 * MiB;
constexpr size_t WS_H = WS_XN + 128 * MiB;
constexpr size_t WS_G = WS_H + 384 * MiB;
constexpr size_t WS_O = WS_G + 384 * MiB;
constexpr size_t WS_STASH = WS_O + 128 * MiB;
constexpr size_t WS_END = WS_STASH + 32 * MiB;
constexpr size_t WS_XB = WS_G + 128 * MiB;
constexpr size_t WS_SSQ = WS_G + 256 * MiB;
constexpr size_t WS_RSTD = WS_SSQ + 1 * MiB;
constexpr size_t WS_Y = WS_H;
constexpr size_t WS_HFF = WS_H + 128 * MiB;
static_assert(WS_HFF + (size_t)M * D_FF * 2 <= WS_XB && WS_XB + (size_t)M * DM * 2 <= WS_SSQ && WS_SSQ + (size_t)M * 8 * 4 <= WS_RSTD && WS_RSTD + (size_t)M * 4 <= WS_O, "HFF overlay / residual stream / row statistics");
constexpr int CW_TMO = 0, CW_CODE = 1;
constexpr int CW_Q = 8192;
constexpr int CW_BAR = 4096;

constexpr int RING_OFF = 0, RING_BYTES = 131072;
constexpr int LDSCTL_OFF = RING_BYTES, MISC_OFF = LDSCTL_OFF + 320;
constexpr int LDS_BYTES = 147456;

#define GAS __attribute__((address_space(1)))
#define LAS __attribute__((address_space(3)))
typedef unsigned short bf16;
typedef unsigned v4u __attribute__((ext_vector_type(4)));
typedef unsigned v2u __attribute__((ext_vector_type(2)));
typedef float f32x4 __attribute__((ext_vector_type(4)));
typedef GAS unsigned gu32;
#define RLX_AGENT __ATOMIC_RELAXED, __HIP_MEMORY_SCOPE_AGENT
#define LDS_WAIT() asm volatile("s_waitcnt lgkmcnt(0)" ::: "memory")
#define VM_WAIT() asm volatile("s_waitcnt vmcnt(0)" ::: "memory")
__device__ __forceinline__ unsigned f2bf(float f) { unsigned u = __builtin_bit_cast(unsigned, f); return (u + 0x7fffu + ((u >> 16) & 1u)) >> 16; }
__device__ __forceinline__ unsigned pk2(float lo, float hi) { return f2bf(lo) | (f2bf(hi) << 16); }
__device__ __forceinline__ float bflo(unsigned w) { return __uint_as_float(w << 16); }
__device__ __forceinline__ float bfhi(unsigned w) { return __uint_as_float(w & 0xffff0000u); }

#define XB_TMO      128
#define XB_XCNT(j)  (256  + 64 * (j))
#define XB_XSUB(j)  (1280 + 64 * (j))
#define XB_XGEN(j)  (2304 + 64 * (j))
#define XB_TOP      3328
#define XB_TOPGEN   3392
#define XCD_BAR_WORDS 3456
#define XB_SPIN_CAP (1u << 18)
__device__ __forceinline__ unsigned xb_ld(unsigned* p)              { return __hip_atomic_load(p, __ATOMIC_RELAXED, __HIP_MEMORY_SCOPE_AGENT); }
__device__ __forceinline__ unsigned xb_add(unsigned* p, unsigned v) { return __hip_atomic_fetch_add(p, v, __ATOMIC_RELAXED, __HIP_MEMORY_SCOPE_AGENT); }
__device__ __forceinline__ unsigned xb_xcc_id() { return (unsigned)__builtin_amdgcn_s_getreg((3 << 11) | 20) & 0xFu; }
#define XB_SPIN(cond, bar) do { unsigned _sp = 0; while (cond) { __builtin_amdgcn_s_sleep(1); \
    if ((++_sp & 255u) == 0u) { if (xb_ld(&(bar)[XB_TMO])) break; if (_sp > XB_SPIN_CAP) { atomicAdd(&(bar)[XB_TMO], 1u); break; } } } } while (0)
struct XcdBarrier { unsigned* bar; unsigned x; volatile LAS unsigned* st; };
__device__ __forceinline__ XcdBarrier xcd_barrier_post(unsigned* bar, volatile LAS unsigned* st) {
    XcdBarrier b; b.bar = bar; b.x = xb_xcc_id(); b.st = st;
    if (threadIdx.x == 0) (void)xb_add(&bar[XB_XCNT(b.x)], 1u);
    return b;
}
__device__ __forceinline__ void xcd_barrier_complete(unsigned* bar, unsigned x, unsigned& nloc, unsigned& nx) {
    const unsigned G = gridDim.x * gridDim.y * gridDim.z;
    unsigned sum, cnt, mine, sp = 0u;
    for (;;) {
        sum = 0u; cnt = 0u; mine = 0u;
#pragma unroll
        for (unsigned j = 0; j < 16; ++j) { const unsigned c = xb_ld(&bar[XB_XCNT(j)]); sum += c; cnt += (c > 0u) ? 1u : 0u; mine = (j == x) ? c : mine; }
        if (sum == G) break;
        __builtin_amdgcn_s_sleep(1);
        if ((++sp & 255u) == 0u) { if (xb_ld(&bar[XB_TMO])) break; if (sp > XB_SPIN_CAP) { atomicAdd(&bar[XB_TMO], 1u); break; } }
    }
    nloc = mine > 0u ? mine : 1u; nx = cnt > 0u ? cnt : 1u;
}
__device__ __forceinline__ void xcd_barrier(const XcdBarrier& b) {
    asm volatile("s_waitcnt vmcnt(0)" ::: "memory");
    __syncthreads();
    if (threadIdx.x == 0) {
        unsigned* bar = b.bar;
        __builtin_amdgcn_s_waitcnt(0);
        unsigned nloc = b.st[0], nx = b.st[1];
        if (nloc == 0u) { xcd_barrier_complete(bar, b.x, nloc, nx); b.st[0] = nloc; b.st[1] = nx; }
        const unsigned old = xb_add(&bar[XB_XSUB(b.x)], 1u);
        const unsigned gen = old / nloc;
        if (old + 1u == (gen + 1u) * nloc) {
            __builtin_amdgcn_fence(__ATOMIC_RELEASE, "agent");
            asm volatile("s_waitcnt vmcnt(0)" ::: "memory");
            const unsigned og = xb_add(&bar[XB_TOP], 1u);
            const unsigned tg = og / nx;
            if (og + 1u == (tg + 1u) * nx) xb_add(&bar[XB_TOPGEN], 1u);
            else XB_SPIN(xb_ld(&bar[XB_TOPGEN]) == tg, bar);
            __builtin_amdgcn_fence(__ATOMIC_ACQUIRE, "agent");
            xb_add(&bar[XB_XGEN(b.x)], 1u);
            asm volatile("s_waitcnt vmcnt(0)" ::: "memory");
        } else {
            XB_SPIN(xb_ld(&bar[XB_XGEN(b.x)]) == gen, bar);
            __builtin_amdgcn_fence(__ATOMIC_ACQUIRE, "agent");
            asm volatile("s_waitcnt vmcnt(0)" ::: "memory");
        }
    }
    __syncthreads();
}

__device__ __forceinline__ float wave_sum(float v) {
#pragma unroll
    for (int o = 1; o < 64; o <<= 1) v += __shfl_xor(v, o);
    return v;
}
__device__ __forceinline__ float wave_max(float v) {
#pragma unroll
    for (int o = 1; o < 64; o <<= 1) v = fmaxf(v, __shfl_xor(v, o));
    return v;
}
__device__ __forceinline__ float softplusf(float z) { return fmaxf(z, 0.f) + log1pf(__expf(-fabsf(z))); }
__device__ __forceinline__ float logsigmoidf(float z) { return fminf(z, 0.f) - __logf(1.f + __expf(-fabsf(z))); }

__device__ __forceinline__ void transpose_item(const float* W, int ld, int K, bf16* WT, int k0, int n0, int drow0, LAS float* scr, int lane, const float* ks) {
#pragma unroll 8
    for (int i = 0; i < 32; ++i) { const int kk = 2 * i + (lane >> 5); scr[kk * 33 + (lane & 31)] = W[(size_t)(k0 + kk) * ld + n0 + (lane & 31)]; }
    LDS_WAIT(); asm volatile("" ::: "memory");
    const int c = lane & 7;
    f32x4 k0v = {1.f, 1.f, 1.f, 1.f}, k1v = k0v;
    if (ks) { k0v = *(const f32x4*)(ks + k0 + 8 * c); k1v = *(const f32x4*)(ks + k0 + 8 * c + 4); }
#pragma unroll
    for (int j = 0; j < 4; ++j) { const int n = (lane >> 3) + 8 * j; const LAS float* s = scr + (8 * c) * 33 + n;
        v4u o; o.x = pk2(s[0 * 33] * k0v.x, s[1 * 33] * k0v.y); o.y = pk2(s[2 * 33] * k0v.z, s[3 * 33] * k0v.w); o.z = pk2(s[4 * 33] * k1v.x, s[5 * 33] * k1v.y); o.w = pk2(s[6 * 33] * k1v.z, s[7 * 33] * k1v.w);
        *(GAS v4u*)(WT + (size_t)(drow0 + n) * K + k0 + 8 * c) = o; }
    LDS_WAIT(); asm volatile("" ::: "memory");
}

struct Args { const float* in[22]; float* out; unsigned char* ws; int s_lo, s_hi, li, pad; };

__device__ __forceinline__ void phase_convert(const Args& a, int l, LAS unsigned char* lds, int wave, int lane, int vcu, int G) {
    LAS float* scr = (LAS float*)(lds + RING_OFF + wave * 16384);
    const int gw = vcu * NWAVES + wave, NGW = G * NWAVES;
    unsigned char* ws = a.ws;
    bf16* Wig = (bf16*)(ws + WS_WIG); bf16* Wbr = (bf16*)(ws + WS_WBR); bf16* Wout = (bf16*)(ws + WS_WOUT); bf16* Wgu = (bf16*)(ws + WS_WGU); bf16* Wdn = (bf16*)(ws + WS_WDN);
    const float* w_in = a.in[2] + (size_t)l * DM * D_IN;
    const float* w_gate = a.in[16] + (size_t)l * DM * D_QKV;
    const float* w_bsb = a.in[13] + (size_t)l * D_SB * DM;
    const float* w_bdf = a.in[14] + (size_t)l * D_DIFF * DM;
    const float* w_bfx = a.in[15] + (size_t)l * D_FOX * DM;
    const float* w_out = a.in[17] + (size_t)l * DM * DM;
    const float* w_fg = a.in[19] + (size_t)l * DM * D_FF;
    const float* w_fu = a.in[20] + (size_t)l * DM * D_FF;
    const float* w_fd = a.in[21] + (size_t)l * D_FF * DM;
    constexpr int I_IN = (DM / 64) * (D_QKV / 32);
    constexpr int I_SB = (D_SB / 64) * (DM / 32);
    constexpr int I_DF = (D_DIFF / 64) * (DM / 32);
    constexpr int I_OUT = (DM / 64) * (DM / 32);
    constexpr int I_FF = (DM / 64) * (D_FF / 32);
    constexpr int I_DN = (D_FF / 64) * (DM / 32);
    constexpr int NITEMS = 2 * I_IN + I_SB + 2 * I_DF + I_OUT + 2 * I_FF + I_DN;
    for (int it = gw; it < NITEMS; it += NGW) {
        int r = it; const float* W; int ld, K, N, mode = 0, ldt = 0, nm = 0; bf16* WT;
        if (r < I_IN) { W = w_in; ld = D_IN; K = DM; N = D_QKV; WT = Wig; nm = 1; }
        else if ((r -= I_IN) < I_IN) { W = w_gate; ld = D_QKV; K = DM; N = D_QKV; WT = Wig + (size_t)D_QKV * DM; nm = 1; }
        else if ((r -= I_IN) < I_SB) { W = w_bsb; ld = DM; K = D_SB; N = DM; WT = Wbr; ldt = DM; }
        else if ((r -= I_SB) < I_DF) { W = w_bdf; ld = DM; K = D_DIFF; N = DM; WT = Wbr + (size_t)DM * DM; ldt = DM; }
        else if ((r -= I_DF) < I_DF) { W = w_bfx; ld = DM; K = D_FOX; N = DM; WT = Wbr + (size_t)2 * DM * DM; ldt = DM; }
        else if ((r -= I_DF) < I_OUT) { W = w_out; ld = DM; K = DM; N = DM; WT = Wout; }
        else if ((r -= I_OUT) < I_FF) { W = w_fg; ld = D_FF; K = DM; N = D_FF; WT = Wgu; mode = 1; }
        else if ((r -= I_FF) < I_FF) { W = w_fu; ld = D_FF; K = DM; N = D_FF; WT = Wgu; mode = 2; }
        else { r -= I_FF; W = w_fd; ld = DM; K = D_FF; N = DM; WT = Wdn; }
        const int nb = N / 32, kb = r / nb, n0 = (r % nb) * 32;
        const int drow0 = mode == 0 ? n0 : (n0 >> 7) * 256 + (n0 & 127) + (mode == 2 ? 128 : 0);
        transpose_item(W, ld, ldt ? ldt : K, WT, kb * 64, n0, drow0, scr, lane, mode ? a.in[18] + l * DM : (nm ? a.in[1] + l * DM : nullptr));
    }
}
template <bool FORGET>
__device__ __forceinline__ void phase_rmsnorm(const float* x, const bf16* xb, bf16* xb_out, const float* g, float* rstd_out, const LAS float* wf, const float* bfg, float* logf, int wave, int lane, int vcu, int G) {
    const int gw = vcu * NWAVES + wave, NGW = G * NWAVES;
    f32x4 gv[8];
#pragma unroll
    for (int j = 0; j < 8; ++j) gv[j] = *(const f32x4*)(g + 4 * lane + 256 * j);
    for (int m = gw; m < M; m += NGW) {
        f32x4 v[8]; float s = 0.f;
        if (x) {
            const GAS f32x4* xr = (const GAS f32x4*)(x + (size_t)m * DM) + lane;
#pragma unroll
            for (int j = 0; j < 8; ++j) v[j] = xr[64 * j];
            GAS unsigned long long* x8 = (GAS unsigned long long*)(xb_out + (size_t)m * DM) + lane;
#pragma unroll
            for (int j = 0; j < 8; ++j) { const unsigned lo = pk2(v[j].x, v[j].y), hi = pk2(v[j].z, v[j].w); x8[64 * j] = (unsigned long long)lo | ((unsigned long long)hi << 32);
                v[j] = (f32x4){bflo(lo), bfhi(lo), bflo(hi), bfhi(hi)}; }
        } else {
            const GAS unsigned long long* xr = (const GAS unsigned long long*)(xb + (size_t)m * DM) + lane;
            unsigned long long t[8];
#pragma unroll
            for (int j = 0; j < 8; ++j) t[j] = xr[64 * j];
#pragma unroll
            for (int j = 0; j < 8; ++j) { const unsigned lo = (unsigned)t[j], hi = (unsigned)(t[j] >> 32); v[j] = (f32x4){bflo(lo), bfhi(lo), bflo(hi), bfhi(hi)}; }
        }
#pragma unroll
        for (int j = 0; j < 8; ++j) s += (v[j].x * v[j].x + v[j].y * v[j].y) + (v[j].z * v[j].z + v[j].w * v[j].w);
        const float rstd = 1.0f / sqrtf(wave_sum(s) * (1.f / DM) + EPS);
#pragma unroll
        for (int j = 0; j < 8; ++j) v[j] = v[j] * rstd * gv[j];
        if (lane == 0) rstd_out[m] = rstd;
        if constexpr (FORGET) {
            float d[5];
#pragma unroll
            for (int h = 0; h < 5; ++h) { float p = 0.f;
#pragma unroll
                for (int j = 0; j < 8; ++j) { const f32x4 w = *(const LAS f32x4*)(wf + h * DM + 4 * lane + 256 * j); p += (v[j].x * w.x + v[j].y * w.y) + (v[j].z * w.z + v[j].w * w.w); }
                d[h] = wave_sum(p); asm volatile("" ::: "memory"); }
            if (lane < 5) { float dv = d[0]; dv = lane == 1 ? d[1] : dv; dv = lane == 2 ? d[2] : dv; dv = lane == 3 ? d[3] : dv; dv = lane == 4 ? d[4] : dv;
                const int b = m / SEQ, s_ = m % SEQ; logf[(size_t)(b * H_FOX + lane) * SEQ + s_] = logsigmoidf(dv + bfg[lane]); }
        }
    }
}

namespace att {
typedef short bf16x8 __attribute__((ext_vector_type(8)));
typedef short s16x4 __attribute__((ext_vector_type(4)));
typedef float f32x16 __attribute__((ext_vector_type(16)));
typedef float f32x4 __attribute__((ext_vector_type(4)));
typedef unsigned u32x4 __attribute__((ext_vector_type(4)));
constexpr int SHM = 16384;
constexpr int L_V = 0, L_K = 2 * SHM, L_BIAS = 4 * SHM, L_WS = L_BIAS + 512, L_FLAG = L_WS + 8 * 256, L_QW = L_FLAG + 128, L_QF = L_QW + 64  , L_END = L_QF + 8 * 4096;
constexpr float LOG2E = 1.4426950408889634f, LN2 = 0.6931471805599453f;
enum { MODE_SB = 0, MODE_DIFF = 1, MODE_FOX = 2 };

__device__ __forceinline__ int kswz(int row, int colB) { return row * 256 + (colB ^ ((row & 7) << 4)); }
__device__ __forceinline__ int v_st(int k, int c) { const int kk = (k & ~0xC) | ((k & 4) << 1) | ((k & 8) >> 1); return ((kk >> 3) * 4 + (c >> 5)) * 512 + ((kk & 7) * 32 + (c & 31)) * 2; }
__device__ __forceinline__ int v_rd_base(int lane) { return ((lane & 3) << 3) | (((lane >> 2) & 3) << 6) | (((lane >> 4) & 1) << 5) | (((lane >> 5) & 1) << 8); }
constexpr int v_rd_off(int d0, int ks, int half) { return d0 * 512 + ks * 4096 + half * 2048; }
__device__ __forceinline__ int crow(int r, int hi) { return (r & 3) + 8 * (r >> 2) + 4 * hi; }
__device__ __forceinline__ unsigned cvtpk(float lo, float hi) { unsigned r; asm volatile("v_cvt_pk_bf16_f32 %0, %1, %2" : "=v"(r) : "v"(lo), "v"(hi)); return r; }
__device__ __forceinline__ void unpack8(bf16x8 v, float* a) { const u32x4 w = __builtin_bit_cast(u32x4, v);
    a[0] = __uint_as_float(w.x << 16); a[1] = __uint_as_float(w.x & 0xffff0000u); a[2] = __uint_as_float(w.y << 16); a[3] = __uint_as_float(w.y & 0xffff0000u);
    a[4] = __uint_as_float(w.z << 16); a[5] = __uint_as_float(w.z & 0xffff0000u); a[6] = __uint_as_float(w.w << 16); a[7] = __uint_as_float(w.w & 0xffff0000u); }
__device__ __forceinline__ bf16x8 pack8f(const float* a) { u32x4 w = {cvtpk(a[0], a[1]), cvtpk(a[2], a[3]), cvtpk(a[4], a[5]), cvtpk(a[6], a[7])}; return __builtin_bit_cast(bf16x8, w); }
__device__ __forceinline__ float swap_max(float v) { auto rr = __builtin_amdgcn_permlane32_swap(__float_as_uint(v), __float_as_uint(v), false, false); return fmaxf(__uint_as_float(rr[0]), __uint_as_float(rr[1])); }
__device__ __forceinline__ float swap_add(float v) { auto rr = __builtin_amdgcn_permlane32_swap(__float_as_uint(v), __float_as_uint(v), false, false); return __uint_as_float(rr[0]) + __uint_as_float(rr[1]); }
template <int CTRL> __device__ __forceinline__ float dpp_mov(float v) { return __builtin_bit_cast(float, __builtin_amdgcn_update_dpp(0, __builtin_bit_cast(int, v), CTRL, 0xf, 0xf, true)); }
__device__ __forceinline__ float sum8(float v) { v += dpp_mov<0xB1>(v); v += dpp_mov<0x4E>(v); v += dpp_mov<0x141>(v); return v; }
__device__ __forceinline__ float sum16(float v) { v = sum8(v); v += dpp_mov<0x140>(v); return v; }
__device__ __forceinline__ float sum32(float v) { v = sum16(v); v += __builtin_bit_cast(float, __builtin_amdgcn_ds_swizzle(__builtin_bit_cast(int, v), 0x401F)); return v; }

template <int ND0, bool INIT = false>
__device__ __forceinline__ void qkt(f32x16& p0, f32x16& p1, const LAS unsigned char* Kb, int d0lo, int r32, int hi, const bf16x8* qr) {
    if (!INIT) {
#pragma unroll
        for (int r = 0; r < 16; ++r) { p0[r] = 0.f; p1[r] = 0.f; } }
#pragma unroll
    for (int d = 0; d < ND0; ++d) { const LAS unsigned char* a = Kb + kswz(r32, (d0lo + d) * 32 + hi * 16);
        const bf16x8 b0 = *(const LAS bf16x8*)a, b1 = *(const LAS bf16x8*)(a + 32 * 256);
        p0 = __builtin_amdgcn_mfma_f32_32x32x16_bf16(b0, qr[d], p0, 0, 0, 0);
        p1 = __builtin_amdgcn_mfma_f32_32x32x16_bf16(b1, qr[d], p1, 0, 0, 0); }
}
template <int ND0>
__device__ __forceinline__ void qkt_lq(f32x16& p0, f32x16& p1, const LAS unsigned char* Kb, int d0lo, int r32, int hi, const LAS unsigned char* qf) {
#pragma unroll
    for (int d = 0; d < ND0; ++d) { const LAS unsigned char* a = Kb + kswz(r32, (d0lo + d) * 32 + hi * 16);
        const bf16x8 b0 = *(const LAS bf16x8*)a, b1 = *(const LAS bf16x8*)(a + 32 * 256), q = *(const LAS bf16x8*)(qf + d * 1024);
        p0 = __builtin_amdgcn_mfma_f32_32x32x16_bf16(b0, q, p0, 0, 0, 0);
        p1 = __builtin_amdgcn_mfma_f32_32x32x16_bf16(b1, q, p1, 0, 0, 0); }
}
__device__ __forceinline__ void pv_tile(f32x16* o, int vb, bf16x8 pa0, bf16x8 pa1, bf16x8 pa2, bf16x8 pa3) {
#define TRRD(dst, off) asm volatile("ds_read_b64_tr_b16 %0, %1 offset:%2" : "=&v"(dst) : "v"(vb), "i"(off) : "memory")
#define PV_D0(d0) do { s16x4 l0, l1, l2, l3, h0, h1, h2, h3; constexpr int b_ = v_rd_off(d0, 0, 0); \
        TRRD(l0, b_); TRRD(h0, b_ + 2048); TRRD(l1, b_ + 4096); TRRD(h1, b_ + 6144); TRRD(l2, b_ + 8192); TRRD(h2, b_ + 10240); TRRD(l3, b_ + 12288); TRRD(h3, b_ + 14336); \
        asm volatile("s_waitcnt lgkmcnt(0)" ::: "memory"); __builtin_amdgcn_sched_barrier(0); \
        o[d0] = __builtin_amdgcn_mfma_f32_32x32x16_bf16(pa0, (bf16x8){l0[0], l0[1], l0[2], l0[3], h0[0], h0[1], h0[2], h0[3]}, o[d0], 0, 0, 0); \
        o[d0] = __builtin_amdgcn_mfma_f32_32x32x16_bf16(pa1, (bf16x8){l1[0], l1[1], l1[2], l1[3], h1[0], h1[1], h1[2], h1[3]}, o[d0], 0, 0, 0); \
        o[d0] = __builtin_amdgcn_mfma_f32_32x32x16_bf16(pa2, (bf16x8){l2[0], l2[1], l2[2], l2[3], h2[0], h2[1], h2[2], h2[3]}, o[d0], 0, 0, 0); \
        o[d0] = __builtin_amdgcn_mfma_f32_32x32x16_bf16(pa3, (bf16x8){l3[0], l3[1], l3[2], l3[3], h3[0], h3[1], h3[2], h3[3]}, o[d0], 0, 0, 0); } while (0)
    PV_D0(0); PV_D0(1); PV_D0(2); PV_D0(3);
#undef PV_D0
#undef TRRD
}
__device__ __forceinline__ void pack_p(const f32x16& p0, const f32x16& p1, bf16x8& pa0, bf16x8& pa1, bf16x8& pa2, bf16x8& pa3) {
#define PK4(P, B_, OUT) do { unsigned a0 = cvtpk(P[B_ + 0], P[B_ + 1]), a1 = cvtpk(P[B_ + 2], P[B_ + 3]); \
        unsigned b0 = cvtpk(P[B_ + 4], P[B_ + 5]), b1 = cvtpk(P[B_ + 6], P[B_ + 7]); \
        auto r0 = __builtin_amdgcn_permlane32_swap(a0, b0, false, false); auto r1 = __builtin_amdgcn_permlane32_swap(a1, b1, false, false); \
        u32x4 w = {r0[0], r1[0], r0[1], r1[1]}; OUT = __builtin_bit_cast(bf16x8, w); } while (0)
    PK4(p0, 0, pa0); PK4(p0, 8, pa1); PK4(p1, 0, pa2); PK4(p1, 8, pa3);
#undef PK4
}

struct Stage { bf16x8 k0, k1, v0, v1; float bias; };
template <int MODE> __device__ __forceinline__ void st_load(Stage& S, const bf16* Kg, const bf16* Vg, const float* cu, int j, int sr, int sc, int tid) {
    const size_t r0 = (size_t)(64 * j + sr) * HLD + sc, r1 = r0 + (size_t)32 * HLD;
    S.k0 = *(const GAS bf16x8*)(Kg + r0); S.k1 = *(const GAS bf16x8*)(Kg + r1);
    S.v0 = *(const GAS bf16x8*)(Vg + r0); S.v1 = *(const GAS bf16x8*)(Vg + r1);
    if (MODE == MODE_FOX) { if (tid < 64) S.bias = cu[64 * j + tid]; }
}
__device__ __forceinline__ float min32(float v) { v = fminf(v, dpp_mov<0xB1>(v)); v = fminf(v, dpp_mov<0x4E>(v)); v = fminf(v, dpp_mov<0x141>(v)); v = fminf(v, dpp_mov<0x140>(v));
    return fminf(v, __builtin_bit_cast(float, __builtin_amdgcn_ds_swizzle(__builtin_bit_cast(int, v), 0x401F))); }
template <int MODE> __device__ __forceinline__ bf16x8 knorm(bf16x8 k) {
    if (MODE == MODE_SB) return k;
    float a[8]; unpack8(k, a);
    float ss = (a[0] * a[0] + a[1] * a[1]) + (a[2] * a[2] + a[3] * a[3]) + (a[4] * a[4] + a[5] * a[5]) + (a[6] * a[6] + a[7] * a[7]);
    ss = (MODE == MODE_FOX) ? sum16(ss) : sum8(ss);
    const float rs = __builtin_amdgcn_rsqf(ss * (MODE == MODE_FOX ? (1.f / 128.f) : (1.f / 64.f)) + EPS);
#pragma unroll
    for (int i = 0; i < 8; ++i) a[i] *= rs;
    return pack8f(a);
}
template <int MODE> __device__ __forceinline__ void st_write(const Stage& S, LAS unsigned char* lds, int buf, int kws, int vst0, int vst1, int tid) {
    const bf16x8 k0 = S.k0, k1 = S.k1;
    *(LAS bf16x8*)(lds + L_K + buf * SHM + kws) = k0; *(LAS bf16x8*)(lds + L_K + buf * SHM + kws + 32 * 256) = k1;
    *(LAS bf16x8*)(lds + L_V + buf * SHM + vst0) = S.v0; *(LAS bf16x8*)(lds + L_V + buf * SHM + vst1) = S.v1;
    if (MODE == MODE_FOX) { if (tid < 64) ((LAS float*)(lds + L_BIAS))[buf * 64 + tid] = -S.bias * LOG2E; }
}

__device__ __forceinline__ void st_load_diff(Stage& S, const bf16* Kg, const bf16* Vg, int j, int sr, int sc, int kr, int kc) {
    const size_t r0 = (size_t)(64 * j + sr) * HLD + sc, r1 = r0 + (size_t)32 * HLD;
    S.k0 = *(const GAS bf16x8*)(Kg + (size_t)(64 * j + kr) * HLD + kc);
    S.v0 = *(const GAS bf16x8*)(Vg + r0); S.v1 = *(const GAS bf16x8*)(Vg + r1);
}
__device__ __forceinline__ void st_write_diff(const Stage& S, LAS unsigned char* lds, int buf, int kwd, int vst0, int vst1) {
    *(LAS bf16x8*)(lds + L_K + buf * SHM + kwd) = S.k0;
    *(LAS bf16x8*)(lds + L_V + buf * SHM + vst0) = S.v0; *(LAS bf16x8*)(lds + L_V + buf * SHM + vst1) = S.v1;
}
__device__ __forceinline__ void softmax_step(f32x16& p0, f32x16& p1, float& m_run, float& l_run, f32x16* o, LAS float* al_l, int r32, int hi, bool first, bf16x8& pa0, bf16x8& pa1, bf16x8& pa2, bf16x8& pa3) {
    float pmax = p0[0];
#pragma unroll
    for (int r = 1; r < 16; ++r) pmax = fmaxf(pmax, p0[r]);
#pragma unroll
    for (int r = 0; r < 16; ++r) pmax = fmaxf(pmax, p1[r]);
    pmax = swap_max(pmax);
    const float shift = first ? pmax : fmaxf(pmax, 0.f);
    const float alpha = first ? 1.f : __builtin_amdgcn_exp2f(-shift);
    m_run += shift;
    if (__any(shift != 0.f)) {
        if (hi == 0) al_l[r32] = alpha;
#pragma unroll
        for (int r = 0; r < 16; ++r) { p0[r] -= shift; p1[r] -= shift; }
        asm volatile("s_waitcnt lgkmcnt(0)" ::: "memory");
#pragma unroll
        for (int g = 0; g < 4; ++g) { const f32x4 f = *(const LAS f32x4*)(al_l + 8 * g + 4 * hi);
#pragma unroll
            for (int d = 0; d < 4; ++d)
#pragma unroll
                for (int i = 0; i < 4; ++i) o[d][4 * g + i] *= f[i]; }
    }
    float ps = 0.f;
#pragma unroll
    for (int r = 0; r < 16; ++r) { p0[r] = __builtin_amdgcn_exp2f(p0[r]); ps += p0[r]; }
#pragma unroll
    for (int r = 0; r < 16; ++r) { p1[r] = __builtin_amdgcn_exp2f(p1[r]); ps += p1[r]; }
    ps = swap_add(ps);
    l_run = l_run * alpha + ps;
    pack_p(p0, p1, pa0, pa1, pa2, pa3);
}
__device__ __forceinline__ void row_table(float x, LAS float* tb, int r32, int hi, float* f) {
    if (hi == 0) tb[r32] = x;
    asm volatile("s_waitcnt lgkmcnt(0)" ::: "memory");
#pragma unroll
    for (int g = 0; g < 4; ++g) { const f32x4 v = *(const LAS f32x4*)(tb + 8 * g + 4 * hi); f[4 * g + 0] = v[0]; f[4 * g + 1] = v[1]; f[4 * g + 2] = v[2]; f[4 * g + 3] = v[3]; }
    asm volatile("s_waitcnt lgkmcnt(0)" ::: "memory");
}
__device__ __forceinline__ void store_o(const f32x16* o, bf16* Ow, int r32, int hi) {
#pragma unroll
    for (int r = 0; r < 16; ++r) { const int orow = crow(r, hi);
#pragma unroll
        for (int d0 = 0; d0 < 4; ++d0) { const float v = o[d0][r]; const float vn = dpp_mov<0xB1>(v);
            if ((r32 & 1) == 0) *(GAS unsigned*)(Ow + (size_t)orow * DM + d0 * 32 + r32) = cvtpk(v, vn); } }
}

struct UnitP { const bf16* H; bf16* O; const float* cum; float* stash; const float* gq; const float* gk; const float* subg; float lam, one_m_li; };

__device__ __forceinline__ void unit_fox(const UnitP& P, int b, int h, int qb, LAS unsigned char* lds) {
    int tid = threadIdx.x; asm volatile("" : "+v"(tid));
    const int wid = __builtin_amdgcn_readfirstlane(tid >> 6), lane = tid & 63, r32 = lane & 31, hi = lane >> 5;
    const int q0 = qb * 256, trow = q0 + 32 * wid + r32, tmin = q0 + 32 * wid; const size_t rb = (size_t)b * SEQ;
    const bf16* Kg = P.H + hslot(KC + h * HD) + rb * HLD; const bf16* Vg = P.H + hslot(VC + h * HD) + rb * HLD; const bf16* Qg = P.H + hslot(QC + h * HD) + (rb + trow) * HLD;
    const float* cu = P.cum + (size_t)(b * H_FOX + h) * SEQ;
    const int sr = tid >> 4, sc = (tid & 15) * 8, kws = kswz(sr, sc * 2), vst0 = v_st(sr, sc), vst1 = v_st(32 + sr, sc);
    const int vb0 = (int)(uintptr_t)(lds + L_V) + v_rd_base(lane);
    LAS float* wsf = (LAS float*)(lds + L_WS) + wid * 64;
    bf16x8 qr[8];
    { float ss = 0.f;
#pragma unroll
      for (int d0 = 0; d0 < 8; ++d0) { qr[d0] = *(const GAS bf16x8*)(Qg + d0 * 16 + hi * 8); float a[8]; unpack8(qr[d0], a);
#pragma unroll
          for (int i = 0; i < 8; ++i) ss += a[i] * a[i]; }
      ss = swap_add(ss);
      const float rs = __builtin_amdgcn_rsqf(ss * (1.f / 128.f) + EPS) * (0.08838834764831845f * LOG2E);
#pragma unroll
      for (int d0 = 0; d0 < 8; ++d0) { float a[8]; unpack8(qr[d0], a); const int d = d0 * 16 + hi * 8;
          const f32x4 g0 = *(const f32x4*)(P.gq + d), g1 = *(const f32x4*)(P.gq + d + 4), k0 = *(const f32x4*)(P.gk + d), k1 = *(const f32x4*)(P.gk + d + 4);
#pragma unroll
          for (int i = 0; i < 4; ++i) { a[i] *= rs * g0[i] * k0[i]; a[4 + i] *= rs * g1[i] * k1[i]; }
          qr[d0] = pack8f(a); } }
    float m_run = 0.f, l_run = 0.f; f32x16 o[4];
#pragma unroll
    for (int d = 0; d < 4; ++d)
#pragma unroll
        for (int r = 0; r < 16; ++r) o[d][r] = 0.f;
    const int NT = 4 * qb + 4, jw = (tmin + 31) >> 6;
    Stage SA, SB; st_load<MODE_FOX>(SA, Kg, Vg, cu, NT - 1, sr, sc, tid); st_write<MODE_FOX>(SA, lds, 0, kws, vst0, vst1, tid);
    __syncthreads();
    st_load<MODE_FOX>(SA, Kg, Vg, cu, NT - 2, sr, sc, tid);
    const int i0 = NT - 1 - jw;
#define FOX_COMPUTE(j_, buf_) do { \
            f32x16 p0, p1; \
            const LAS float* bb = (const LAS float*)(lds + L_BIAS) + (buf_) * 64 + 4 * hi; \
            _Pragma("unroll") for (int g = 0; g < 4; ++g) { const f32x4 x = *(const LAS f32x4*)(bb + 8 * g), y = *(const LAS f32x4*)(bb + 32 + 8 * g); \
                _Pragma("unroll") for (int i2 = 0; i2 < 4; ++i2) { p0[4 * g + i2] = x[i2] - m_run; p1[4 * g + i2] = y[i2] - m_run; } } \
            qkt<8, true>(p0, p1, lds + L_K + (buf_) * SHM, 0, r32, hi, qr); \
            if (64 * (j_) + 63 > tmin) { const int dq = trow - 64 * (j_) - 4 * hi; const float NEG = -__builtin_inff(); \
                _Pragma("unroll") for (int r = 0; r < 16; ++r) { const int c = (r & 3) + 8 * (r >> 2); if (c > dq) p0[r] = NEG; if (c + 32 > dq) p1[r] = NEG; } } \
            bf16x8 pa0, pa1, pa2, pa3; \
            softmax_step(p0, p1, m_run, l_run, o, wsf, r32, hi, (j_) == jw, pa0, pa1, pa2, pa3); \
            pv_tile(o, vb0 + (buf_) * SHM, pa0, pa1, pa2, pa3); } while (0)
    for (int i = 0; i < NT; i += 2) {
        { const int j = NT - 1 - i;
          if (i + 2 < NT) st_load<MODE_FOX>(SB, Kg, Vg, cu, j - 2, sr, sc, tid);
          if (i >= i0) FOX_COMPUTE(j, 0);
          st_write<MODE_FOX>(SA, lds, 1, kws, vst0, vst1, tid);
          __syncthreads(); }
        { const int j = NT - 2 - i;
          if (i + 3 < NT) st_load<MODE_FOX>(SA, Kg, Vg, cu, j - 2, sr, sc, tid);
          if (i + 1 >= i0) FOX_COMPUTE(j, 1);
          if (i + 2 < NT) st_write<MODE_FOX>(SB, lds, 0, kws, vst0, vst1, tid);
          __syncthreads(); }
    }
#undef FOX_COMPUTE
    float rl[16]; row_table(__builtin_amdgcn_rcpf(l_run), wsf + 32, r32, hi, rl);
#pragma unroll
    for (int d = 0; d < 4; ++d)
#pragma unroll
        for (int r = 0; r < 16; ++r) o[d][r] *= rl[r];
    store_o(o, P.O + (rb + tmin) * DM + OC + h * HD, r32, hi);
}

__device__ __forceinline__ void unit_diff(const UnitP& P, int b, int h, int qb, float slope2, LAS unsigned char* lds) {
    int tid = threadIdx.x; asm volatile("" : "+v"(tid));
    const int wid = __builtin_amdgcn_readfirstlane(tid >> 6), lane = tid & 63, r32 = lane & 31, hi = lane >> 5;
    const int q0 = qb * 256, trow = q0 + 32 * wid + r32, tmin = q0 + 32 * wid; const size_t rb = (size_t)b * SEQ;
    const bf16* Kg = P.H + hslot(KB_ + h * HD) + rb * HLD; const bf16* Vg = P.H + hslot(VB_ + h * HD) + rb * HLD; const bf16* Qg = P.H + hslot(QB_ + h * HD) + (rb + trow) * HLD;
    const int sr = tid >> 4, sc = (tid & 15) * 8, kws = kswz(sr, sc * 2), vst0 = v_st(sr, sc), vst1 = v_st(32 + sr, sc);
    const int vb0 = (int)(uintptr_t)(lds + L_V) + v_rd_base(lane);
    LAS float* wsf = (LAS float*)(lds + L_WS) + wid * 64;
    const int NT = 4 * qb + 4, jw = tmin >> 6;
    float* stash = P.stash + (size_t)blockIdx.x * 32768;
    LAS unsigned char* qf = lds + L_QF + wid * 4096 + lane * 16;
    f32x16 o[4];
    for (int mp = 0; mp < 2; ++mp) {
        bf16x8 qr[4];
        { float ss = 0.f, qn2 = 0.f;
          int tq = trow; asm volatile("" : "+v"(tq));
          const bf16* Qp = P.H + hslot(QB_ + h * HD) + (rb + tq) * HLD + mp * 64 + hi * 8;
#pragma unroll
          for (int d = 0; d < 4; ++d) { qr[d] = *(const GAS bf16x8*)(Qp + d * 16); float a[8]; unpack8(qr[d], a);
#pragma unroll
              for (int i = 0; i < 8; ++i) ss += a[i] * a[i]; }
          ss = swap_add(ss);
          const float rs = __builtin_amdgcn_rsqf(ss * (1.f / 64.f) + EPS) * (0.125f * LOG2E);
#pragma unroll
          for (int d = 0; d < 4; ++d) { float a[8]; unpack8(qr[d], a); const int dd = d * 16 + hi * 8;
              const f32x4 g0 = *(const f32x4*)(P.gq + dd), g1 = *(const f32x4*)(P.gq + dd + 4), k0 = *(const f32x4*)(P.gk + dd), k1 = *(const f32x4*)(P.gk + dd + 4);
#pragma unroll
              for (int i = 0; i < 4; ++i) { a[i] *= rs * g0[i] * k0[i]; a[4 + i] *= rs * g1[i] * k1[i]; }
#pragma unroll
              for (int i = 0; i < 8; ++i) qn2 += a[i] * a[i];
              *(LAS bf16x8*)(qf + d * 1024) = pack8f(a); }
          qn2 = swap_add(qn2);
          const float need = (152.0f + 16.4f * sqrtf(qn2)) / slope2;
          const float smin = min32((float)trow - need);
          if (lane == 0) ((LAS float*)(lds + L_FLAG))[16 + wid] = smin; }
        float m_run = 0.f, l_run = 0.f;
#pragma unroll
        for (int d = 0; d < 4; ++d)
#pragma unroll
            for (int r = 0; r < 16; ++r) o[d][r] = 0.f;
        const int kr = tid >> 3, kc = mp * 64 + (tid & 7) * 8, kwd = kswz(kr, kc * 2);
        Stage S; st_load_diff(S, Kg, Vg, NT - 1, sr, sc, kr, kc); st_write_diff(S, lds, 0, kwd, vst0, vst1);
        __syncthreads();
        int jlo;
        { const LAS f32x4* f4 = (const LAS f32x4*)((LAS float*)(lds + L_FLAG) + 16); const f32x4 fa = f4[0], fb = f4[1];
          const float sm = fminf(fminf(fminf(fa[0], fa[1]), fminf(fa[2], fa[3])), fminf(fminf(fb[0], fb[1]), fminf(fb[2], fb[3])));
          jlo = __builtin_amdgcn_readfirstlane((int)(fmaxf(sm, 0.f) * (1.0f / 64.0f))); if (jlo > NT - 4) jlo = NT - 4; }
        const int NE = NT - jlo;
        const int i0 = NT - 1 - jw;
        for (int i = 0; i < i0; ++i) {
            const int buf = i & 1, j = NT - 1 - i;
            st_load_diff(S, Kg, Vg, j - 1, sr, sc, kr, kc);
            st_write_diff(S, lds, buf ^ 1, kwd, vst0, vst1);
            __syncthreads();
        }
        for (int i = i0; i < NE; ++i) {
            const int buf = i & 1, j = NT - 1 - i;
            if (i + 1 < NE) st_load_diff(S, Kg, Vg, j - 1, sr, sc, kr, kc);
            {
                f32x16 p0, p1;
                const float dq = (float)(trow - 64 * j - 4 * hi);
                const float nm = -m_run;
#pragma unroll
                for (int r = 0; r < 16; ++r) { const float c = (float)((r & 3) + 8 * (r >> 2)); p0[r] = fmaf(-slope2, fabsf(dq - c), nm); p1[r] = fmaf(-slope2, fabsf(dq - (c + 32.f)), nm); }
                qkt_lq<4>(p0, p1, lds + L_K + buf * SHM, mp * 4, r32, hi, qf);
                bf16x8 pa0, pa1, pa2, pa3;
                softmax_step(p0, p1, m_run, l_run, o, wsf, r32, hi, j == jw, pa0, pa1, pa2, pa3);
                pv_tile(o, vb0 + buf * SHM, pa0, pa1, pa2, pa3);
            }
            if (i + 1 < NE) st_write_diff(S, lds, buf ^ 1, kwd, vst0, vst1);
            __syncthreads();
        }
        float rl[16]; row_table(__builtin_amdgcn_rcpf(l_run), wsf + 32, r32, hi, rl);
        int tso = tid; asm volatile("" : "+v"(tso));
        GAS char* stp = (GAS char*)stash + (size_t)tso * 16;
        if (mp == 0) {
#pragma unroll
            for (int d = 0; d < 4; ++d)
#pragma unroll
                for (int g = 0; g < 4; ++g) { f32x4 v; v[0] = o[d][4 * g] * rl[4 * g]; v[1] = o[d][4 * g + 1] * rl[4 * g + 1]; v[2] = o[d][4 * g + 2] * rl[4 * g + 2]; v[3] = o[d][4 * g + 3] * rl[4 * g + 3];
                    *(GAS f32x4*)stp = v; stp += 8192; asm volatile("" : "+v"(stp)); }
        } else {
#pragma unroll
            for (int d = 0; d < 4; ++d)
#pragma unroll
                for (int g = 0; g < 4; ++g) { const f32x4 v = *(const GAS f32x4*)stp; stp += 8192; asm volatile("" : "+v"(stp));
#pragma unroll
                    for (int i = 0; i < 4; ++i) o[d][4 * g + i] = v[i] - P.lam * (o[d][4 * g + i] * rl[4 * g + i]); }
        }
    }
    const f32x4 sg = (f32x4){P.subg[r32], P.subg[32 + r32], P.subg[64 + r32], P.subg[96 + r32]} * P.one_m_li;
#pragma unroll
    for (int r = 0; r < 16; ++r) { float s = (o[0][r] * o[0][r] + o[1][r] * o[1][r]) + (o[2][r] * o[2][r] + o[3][r] * o[3][r]);
        s = sum32(s);
        const float rs = __builtin_amdgcn_rsqf(s * (1.f / 128.f) + EPS);
        o[0][r] *= rs * sg[0]; o[1][r] *= rs * sg[1]; o[2][r] *= rs * sg[2]; o[3][r] *= rs * sg[3]; }
    store_o(o, P.O + (rb + tmin) * DM + OB + h * HD, r32, hi);
}

__device__ __forceinline__ void unit_sb(const UnitP& P, int b, int h, int qb, LAS unsigned char* lds) {
    int tid = threadIdx.x; asm volatile("" : "+v"(tid));
    const int wid = __builtin_amdgcn_readfirstlane(tid >> 6), lane = tid & 63, r32 = lane & 31, hi = lane >> 5;
    const int q0 = qb * 256, trow = q0 + 32 * wid + r32, tmin = q0 + 32 * wid; const size_t rb = (size_t)b * SEQ;
    const bf16* Kg = P.H + hslot(KA + h * HD) + rb * HLD; const bf16* Vg = P.H + hslot(VA + h * HD) + rb * HLD; const bf16* Qg = P.H + hslot(QA + h * HD) + (rb + trow) * HLD;
    const int sr = tid >> 4, sc = (tid & 15) * 8, kws = kswz(sr, sc * 2), vst0 = v_st(sr, sc), vst1 = v_st(32 + sr, sc);
    const int vb0 = (int)(uintptr_t)(lds + L_V) + v_rd_base(lane);
    LAS unsigned* flags = (LAS unsigned*)(lds + L_FLAG);
    bf16x8 qr[8];
#pragma unroll
    for (int d0 = 0; d0 < 8; ++d0) qr[d0] = *(const GAS bf16x8*)(Qg + d0 * 16 + hi * 8);
    f32x16 o[4];
#pragma unroll
    for (int d = 0; d < 4; ++d)
#pragma unroll
        for (int r = 0; r < 16; ++r) o[d][r] = 0.f;
    const int jtop = 4 * qb + 3, NT = jtop + 1;
    const int jw = (tmin + 30) >> 6;
    float carry = 0.f; bool done = false;
    Stage S; st_load<MODE_SB>(S, Kg, Vg, nullptr, jtop, sr, sc, tid); st_write<MODE_SB>(S, lds, 0, kws, vst0, vst1, tid);
    __syncthreads();
    for (int i = 0; i < NT; ++i) {
        const int buf = i & 1, j = jtop - i;
        if (i + 1 < NT) st_load<MODE_SB>(S, Kg, Vg, nullptr, j - 1, sr, sc, tid);
        if (j <= jw && !done) {
            f32x16 z0, z1; qkt<8>(z0, z1, lds + L_K + buf * SHM, 0, r32, hi, qr);
            const int dq = trow - 64 * j - 4 * hi;
            const bool need_mask = 64 * j + 63 >= tmin;
            f32x16 l0, l1;
            typedef float f32x2_ __attribute__((ext_vector_type(2)));
            constexpr float CS = 0.08838834764831845f * LOG2E;
#pragma unroll
            for (int r = 0; r < 16; r += 2) { const int c = (r & 3) + 8 * (r >> 2);
                const f32x2_ u0 = (f32x2_){z0[r], z0[r + 1]} * CS, u1 = (f32x2_){z1[r], z1[r + 1]} * CS;
                const f32x2_ d0 = (f32x2_){__builtin_amdgcn_exp2f(-fabsf(u0.x)), __builtin_amdgcn_exp2f(-fabsf(u0.y))} + 1.0f, d1 = (f32x2_){__builtin_amdgcn_exp2f(-fabsf(u1.x)), __builtin_amdgcn_exp2f(-fabsf(u1.y))} + 1.0f;
                f32x2_ s0 = (f32x2_){fmaxf(u0.x, 0.f), fmaxf(u0.y, 0.f)} + (f32x2_){__builtin_amdgcn_logf(d0.x), __builtin_amdgcn_logf(d0.y)};
                f32x2_ s1 = (f32x2_){fmaxf(u1.x, 0.f), fmaxf(u1.y, 0.f)} + (f32x2_){__builtin_amdgcn_logf(d1.x), __builtin_amdgcn_logf(d1.y)};
                if (need_mask) { if (!(c < dq)) s0.x = 0.f; if (!(c + 1 < dq)) s0.y = 0.f; if (!(c + 32 < dq)) s1.x = 0.f; if (!(c + 33 < dq)) s1.y = 0.f; }
                z0[r] = u0.x; z0[r + 1] = u0.y; z1[r] = u1.x; z1[r + 1] = u1.y;
                l0[r] = -s0.x; l0[r + 1] = -s0.y; l1[r] = -s1.x; l1[r + 1] = -s1.y; }
            float run = carry;
#pragma unroll
            for (int mm = 7; mm >= 0; --mm) {
                float t;
                if (mm >= 4) { const int m = mm - 4; t = (l1[4 * m] + l1[4 * m + 1]) + (l1[4 * m + 2] + l1[4 * m + 3]); } else { t = (l0[4 * mm] + l0[4 * mm + 1]) + (l0[4 * mm + 2] + l0[4 * mm + 3]); }
                auto rr = __builtin_amdgcn_permlane32_swap(__float_as_uint(t), __float_as_uint(t), false, false);
                const float T0 = __uint_as_float(rr[0]), T1 = __uint_as_float(rr[1]);
                const float e1 = run, e0 = run + T1; float ex = hi ? e1 : e0; run = e0 + T0;
                if (mm >= 4) { const int m = mm - 4;
#pragma unroll
                    for (int i2 = 3; i2 >= 0; --i2) { ex += l1[4 * m + i2]; l1[4 * m + i2] = ex; } }
                else {
#pragma unroll
                    for (int i2 = 3; i2 >= 0; --i2) { ex += l0[4 * mm + i2]; l0[4 * mm + i2] = ex; } }
            }
            carry = run;
#pragma unroll
            for (int r = 0; r < 16; r += 2) { const int c = (r & 3) + 8 * (r >> 2);
                const f32x2_ t0 = (f32x2_){z0[r], z0[r + 1]} + (f32x2_){l0[r], l0[r + 1]}, t1 = (f32x2_){z1[r], z1[r + 1]} + (f32x2_){l1[r], l1[r + 1]};
                float w0 = __builtin_amdgcn_exp2f(t0.x), w0b = __builtin_amdgcn_exp2f(t0.y), w1 = __builtin_amdgcn_exp2f(t1.x), w1b = __builtin_amdgcn_exp2f(t1.y);
                if (need_mask) { if (!(c < dq)) w0 = 0.f; if (!(c + 1 < dq)) w0b = 0.f; if (!(c + 32 < dq)) w1 = 0.f; if (!(c + 33 < dq)) w1b = 0.f; }
                z0[r] = w0; z0[r + 1] = w0b; z1[r] = w1; z1[r + 1] = w1b; }
            bf16x8 pa0, pa1, pa2, pa3; pack_p(z0, z1, pa0, pa1, pa2, pa3);
            pv_tile(o, vb0 + buf * SHM, pa0, pa1, pa2, pa3);
            done = __all(carry < -110.f * LOG2E);
        }
        if (lane == 0) flags[(i & 1) * 8 + wid] = (done || j == 0) ? 1u : 0u;
        if (i + 1 < NT) st_write<MODE_SB>(S, lds, buf ^ 1, kws, vst0, vst1, tid);
        __syncthreads();
        { const LAS u32x4* f4 = (const LAS u32x4*)(flags + (i & 1) * 8); const u32x4 fa = f4[0], fb = f4[1];
          if ((fa.x & fa.y & fa.z & fa.w & fb.x & fb.y & fb.z & fb.w) != 0u) break; }
    }
    store_o(o, P.O + (rb + tmin) * DM + OA + h * HD, r32, hi);
    __syncthreads();
}
}

__device__ __forceinline__ int q_pop(gu32* ctr, LAS unsigned char* lds) {
    if (threadIdx.x == 0) *(volatile LAS unsigned*)(lds + att::L_QW) = __hip_atomic_fetch_add(ctr, 1u, RLX_AGENT);
    __syncthreads();
    const unsigned v = *(volatile LAS unsigned*)(lds + att::L_QW);
    __syncthreads();
    return __builtin_amdgcn_readfirstlane((int)v);
}
__device__ __forceinline__ void attention_phase(const Args& a, int l, LAS unsigned char* lds, gu32* ctl, int rep) {
    const float lambda_init = 0.8f - 0.6f * expf(-0.3f * (float)l);
    float lam;
    { const int lane = threadIdx.x & 63; const float p1 = wave_sum(a.in[6][l * 64 + lane] * a.in[7][l * 64 + lane]), p2 = wave_sum(a.in[8][l * 64 + lane] * a.in[9][l * 64 + lane]); lam = __builtin_bit_cast(float, __builtin_amdgcn_readfirstlane(__builtin_bit_cast(int, expf(p1) - expf(p2) + lambda_init))); }
    att::UnitP P; P.H = (const bf16*)(a.ws + WS_H); P.O = (bf16*)(a.ws + WS_O); P.cum = (const float*)(a.ws + WS_CUM); P.stash = (float*)(a.ws + WS_STASH);
    P.subg = a.in[10] + l * 128; P.lam = lam; P.one_m_li = 1.0f - lambda_init;
    const int xme = (int)(xb_xcc_id() & 7u);
    gu32* qc = ctl + CW_Q + (l * 3) * 8 * 64; (void)rep;
    P.gq = a.in[4] + l * 64; P.gk = a.in[5] + l * 64;
    for (int dx = 0; dx < 8; ++dx) { const int x = (xme + dx) & 7; constexpr int NB = BATCH * H_DIFF / 8;
        for (;;) { const int li = q_pop(qc + (0 * 8 + x) * 64, lds); if (li >= NB * 8) break;
            const int qb = 7 - li / NB, bh = x + 8 * (li % NB), h = bh % H_DIFF;
            att::unit_diff(P, bh / H_DIFF, h, qb, exp2f(-8.0f * (float)(h + 1) / 5.0f) * att::LOG2E, lds); } }
    P.gq = a.in[11] + l * 128; P.gk = a.in[12] + l * 128;
    for (int dx = 0; dx < 8; ++dx) { const int x = (xme + dx) & 7; constexpr int NB = BATCH * H_FOX / 8;
        for (;;) { const int li = q_pop(qc + (1 * 8 + x) * 64, lds); if (li >= NB * 8) break;
            const int qb = 7 - li / NB, bh = x + 8 * (li % NB);
            att::unit_fox(P, bh / H_FOX, bh % H_FOX, qb, lds); } }
    for (int dx = 0; dx < 8; ++dx) { const int x = (xme + dx) & 7; constexpr int NB = BATCH * H_SB / 8;
        for (;;) { const int li = q_pop(qc + (2 * 8 + x) * 64, lds); if (li >= NB * 8) break;
            const int qb = 7 - li / NB, bh = x + 8 * (li % NB);
            att::unit_sb(P, bh / H_SB, bh % H_SB, qb, lds); } }
}

__device__ __forceinline__ void phase_scan(const float* logf, float* cum, LAS unsigned char* lds, int tid, int wave, int lane, int G) {
    LAS float* wtot = (LAS float*)(lds);
    for (int seq = blockIdx.x; seq < BATCH * H_FOX; seq += G) {
        const f32x4 v = *(const f32x4*)(logf + (size_t)seq * SEQ + 4 * tid);
        const float p0 = v.x, p1 = p0 + v.y, p2 = p1 + v.z, p3 = p2 + v.w;
        float inc = p3;
#pragma unroll
        for (int off = 1; off < 64; off <<= 1) { const float o = __shfl_up(inc, off); if (lane >= off) inc += o; }
        if (lane == 63) wtot[wave] = inc;
        LDS_WAIT(); __syncthreads();
        float base = inc - p3;
        for (int w = 0; w < wave; ++w) base += wtot[w];
        *(f32x4*)(cum + (size_t)seq * SEQ + 4 * tid) = (f32x4){base + p0, base + p1, base + p2, base + p3};
        __syncthreads();
    }
}

__global__ void __launch_bounds__(NWAVES * 64, 2) mega_fwd(Args args) {
    extern __shared__ __attribute__((aligned(16))) unsigned char lds_raw[];
    LAS unsigned char* lds = (LAS unsigned char*)lds_raw;
    volatile LAS unsigned* MISC = (volatile LAS unsigned*)(lds + MISC_OFF);
    const int G = gridDim.x; const int bx = blockIdx.x; const int vcu = (G % 8 == 0) ? (bx % 8) * (G / 8) + bx / 8 : bx;
#define TID_OPAQUE() int tid = threadIdx.x; asm volatile("" : "+v"(tid)); const int lane = tid & 63, wave = __builtin_amdgcn_readfirstlane(tid >> 6); (void)lane; (void)wave
    unsigned char* ws = args.ws;
    gu32* ctl = (gu32*)(ws + WS_CTL);
    for (int u = threadIdx.x; u < (LDS_BYTES - LDSCTL_OFF) / 4; u += NWAVES * 64) ((LAS unsigned*)(lds + LDSCTL_OFF))[u] = 0u;
    __syncthreads();
    XcdBarrier bar = xcd_barrier_post((unsigned*)(ctl + CW_BAR) + args.li * XCD_BAR_WORDS, MISC + 8);

    bf16* Wig = (bf16*)(ws + WS_WIG); bf16* Wbr = (bf16*)(ws + WS_WBR); bf16* Wout = (bf16*)(ws + WS_WOUT); bf16* Wgu = (bf16*)(ws + WS_WGU); bf16* Wdn = (bf16*)(ws + WS_WDN);
    float* logf = (float*)(ws + WS_LOGF); float* cum = (float*)(ws + WS_CUM);
    bf16* HB = (bf16*)(ws + WS_H); bf16* GB = (bf16*)(ws + WS_G); bf16* OBF = (bf16*)(ws + WS_O); bf16* YB = (bf16*)(ws + WS_Y); bf16* HFF = (bf16*)(ws + WS_HFF); bf16* XB = (bf16*)(ws + WS_XB); float* SSQ = (float*)(ws + WS_SSQ); float* RSTD = (float*)(ws + WS_RSTD);
    float* out = args.out;

    const int s_lo = args.s_lo, s_hi = args.s_hi;
#define IN(s) (s_lo <= (s) && (s) < s_hi)
#define SEAM(s) do { if (IN(s) && IN((s) + 1)) xcd_barrier(bar); } while (0)
    for (int l = 0; l < DEPTH; ++l) {
        const int sb = l * NPH;
        if (sb + NPH <= s_lo || sb >= s_hi) continue;
        if (IN(sb + 0)) for (int rep = 0; rep < (PROBE_REP == 0 ? 2 : 1); ++rep) {
            TID_OPAQUE();
            phase_convert(args, l, lds, wave, lane, vcu, G);
            __syncthreads();
            { const float* w_in = args.in[2] + (size_t)l * DM * D_IN; LAS float* wf = (LAS float*)(lds + RING_OFF);
              for (int k = tid; k < DM; k += NWAVES * 64) { const float* wr_ = w_in + (size_t)k * D_IN + D_QKV;
#pragma unroll
                  for (int h = 0; h < 5; ++h) wf[h * DM + k] = wr_[h]; }
              LDS_WAIT(); __syncthreads();
              phase_rmsnorm<true>(l == 0 ? args.in[0] : nullptr, XB, XB, args.in[1] + l * DM, RSTD, wf, args.in[3] + l * H_FOX, logf, wave, lane, vcu, G);
              __syncthreads(); }
        }
        SEAM(sb + 0);
        if (IN(sb + 1)) for (int rep = 0; rep < (PROBE_REP == 1 ? 2 : 1); ++rep) {
            { TID_OPAQUE(); phase_scan(logf, cum, lds, tid, wave, lane, G); }
            const pg8::Gemm g = pg8::mk_gemm(XB, Wig, M, D_QKV, DM, DM, DM); pg8::StaticOrder S; S.init(M, D_QKV, G, bx);
            pg8::EpiInProj E{HB, HLD, (size_t)M * HLD, (LAS float*)(lds + LDSCTL_OFF + 1024), RSTD, (LAS float*)(lds + LDSCTL_OFF + 1024 + 8192)};
            pg8::gemm_phase<pg8::EpiInProj, pg8::StaticOrder, true, true>(lds + RING_OFF, g, S, E);
        }
        SEAM(sb + 1);
        if (IN(sb + 2)) { attention_phase(args, l, lds, ctl, 0); __syncthreads(); }
        SEAM(sb + 2);
        if (IN(sb + 3)) for (int rep = 0; rep < (PROBE_REP == 3 ? 2 : 1); ++rep) {
            pg8::Gemm g = pg8::mk_gemm(XB, Wig + (size_t)D_QKV * DM, M, DM, DM, DM, DM);
            g.b_stride = DM * DM; g.A_alt = OBF + OA; g.a_off1 = OB - OA; g.a_off2 = OC - OB; g.B_alt = Wbr; g.b_stride_alt = DM * DM; g.K_alt = D_SB; g.k_dec = D_SB - D_DIFF;
            pg8::SixOrder S; S.S.init(M, DM, G, bx);
            pg8::EpiGateBranch E{GB + (size_t)bx * 65536, YB, DM, RSTD, (LAS float*)(lds + LDSCTL_OFF + 1024 + 8192)};
            pg8::gemm_phase<pg8::EpiGateBranch, pg8::SixOrder, false, true>(lds + RING_OFF, g, S, E);
        }
        SEAM(sb + 3);
        if (IN(sb + 4)) {
            const pg8::Gemm g = pg8::mk_gemm(YB, Wout, M, DM, DM, DM, DM); pg8::StaticOrder S; S.init(M, DM, G, bx);
            pg8::EpiResid E{XB, XB, nullptr, DM, SSQ, (LAS float*)(lds + LDSCTL_OFF + 1024)};
            pg8::gemm_phase<pg8::EpiResid, pg8::StaticOrder, true, true>(lds + RING_OFF, g, S, E);
        }
        SEAM(sb + 4);
        if (IN(sb + 6)) for (int rep = 0; rep < (PROBE_REP == 6 ? 2 : 1); ++rep) {
            const pg8::Gemm g = pg8::mk_gemm(XB, Wgu, M, NGU, DM, DM, DM); pg8::StaticOrder S; S.init(M, NGU, G, bx);
            pg8::EpiSwiglu E{HFF, D_FF, SSQ, (LAS float*)(lds + LDSCTL_OFF + 1024), 1.f / DM, EPS};
            pg8::gemm_phase<pg8::EpiSwiglu, pg8::StaticOrder, true, true>(lds + RING_OFF, g, S, E);
        }
        SEAM(sb + 6);
        if (IN(sb + 7)) {
            const pg8::Gemm g = pg8::mk_gemm(HFF, Wdn, M, DM, D_FF, D_FF, D_FF); pg8::StaticOrder S; S.init(M, DM, G, bx);
            pg8::EpiResid E{XB, XB, l == DEPTH - 1 ? out : nullptr, DM, nullptr, (LAS float*)(lds + LDSCTL_OFF + 1024)};
            pg8::gemm_phase<pg8::EpiResid, pg8::StaticOrder, true, true>(lds + RING_OFF, g, S, E);
        }
        SEAM(sb + 7);
    }
#undef IN
#undef SEAM
}

extern "C" void kernel_launch(void* const* d_in, const int* in_sizes, int n_in, void* d_out, int out_size, void* d_ws, size_t ws_size, hipStream_t stream) {
    static int grid = 0;
    if (grid == 0) {
        if (n_in != 22 || in_sizes[0] != M * DM || out_size != M * DM || ws_size < WS_END) {
            fprintf(stderr, "kernel_launch: unexpected shapes (n_in %d, in0 %d, out %d, ws %zu, need %zu)\n", n_in, n_in > 0 ? in_sizes[0] : -1, out_size, ws_size, (size_t)WS_END); grid = -1; return; }
        int dev = 0, cus = 0, per_cu = 0;
        if (hipGetDevice(&dev) != hipSuccess || hipDeviceGetAttribute(&cus, hipDeviceAttributeMultiprocessorCount, dev) != hipSuccess) { grid = -1; return; }
        if (hipFuncSetAttribute((const void*)mega_fwd, hipFuncAttributeMaxDynamicSharedMemorySize, LDS_BYTES) != hipSuccess) { fprintf(stderr, "kernel_launch: hipFuncSetAttribute failed\n"); grid = -1; return; }
        if (hipOccupancyMaxActiveBlocksPerMultiprocessor(&per_cu, (const void*)mega_fwd, NWAVES * 64, LDS_BYTES) != hipSuccess || per_cu < 1)
            fprintf(stderr, "kernel_launch: occupancy query reports %d workgroups per CU\n", per_cu);
        (void)hipGetLastError();
        grid = cus;
    }
    if (grid < 0) return;
    if (hipMemsetAsync((char*)d_ws + WS_CTL, 0, CTL_ZERO_BYTES, stream) != hipSuccess) return;
    Args a{};
    for (int i = 0; i < 22; ++i) a.in[i] = (const float*)d_in[i];
    a.out = (float*)d_out; a.ws = (unsigned char*)d_ws; a.pad = 0;
#if MK_ONE_LAUNCH
    a.s_lo = 0; a.s_hi = NSTEP; a.li = 0;
    hipLaunchKernelGGL(mega_fwd, dim3(grid), dim3(NWAVES * 64), LDS_BYTES, stream, a);
#else
    for (int s = 0; s < NSTEP; ++s) {
        a.s_lo = s; a.s_hi = s + 1; a.li = s;
        hipLaunchKernelGGL(mega_fwd, dim3(grid), dim3(NWAVES * 64), LDS_BYTES, stream, a);
    }
#endif
}
```

```cpp
#include <hip/hip_runtime.h>
#include <cstdio>
#include <cstdint>

#ifndef PROBE_REP
#define PROBE_REP (-1)
#endif
#ifndef MK_ONE_LAUNCH
#define MK_ONE_LAUNCH 1
#endif

namespace pg8 {
#define PG8_LAS __attribute__((address_space(3)))
typedef unsigned short bf16_t;
typedef short bf16x8 __attribute__((ext_vector_type(8)));
typedef float f32x4 __attribute__((ext_vector_type(4)));
typedef unsigned u32x4 __attribute__((ext_vector_type(4)));
constexpr int BM = 256, BK = 64, HALF = 128, HTB = HALF * BK * 2, STAGE_BYTES = 8 * HTB, NXCD = 8, WGM = 4;

__host__ __device__ __forceinline__ int lds_byte(int r, int c) { const int st = r >> 3, rr = r & 7, ch = c >> 3, g = (r >> 1) & 7; return st * 1024 + rr * 128 + ((ch ^ g) * 16) + (c & 7) * 2; }
__host__ __device__ __forceinline__ void stage_rc(int b, int& R, int& C) { const int st = b / 1024, sb = b % 1024, rr = sb / 128, pch = (sb % 128) / 16; R = st * 8 + rr; C = (pch ^ ((R >> 1) & 7)) * 8; }
__host__ __device__ __forceinline__ int perm32(int rho) { const int n = rho >> 4, i = rho & 15; return 8 * (i >> 2) + 4 * n + (i & 3); }

struct Unit { int pm, pn, br; };
struct Gemm { const bf16_t* A; const bf16_t* Bt; int M, N, K, lda, ldb;
              int a_off1, a_off2, b_stride, k_dec;
              const bf16_t* A_alt; const bf16_t* B_alt; int b_stride_alt, K_alt; };
__device__ __forceinline__ Gemm mk_gemm(const bf16_t* A, const bf16_t* Bt, int M, int N, int K, int lda, int ldb) { Gemm g; g.A = A; g.Bt = Bt; g.M = M; g.N = N; g.K = K; g.lda = lda; g.ldb = ldb; g.a_off1 = 0; g.a_off2 = 0; g.b_stride = 0; g.k_dec = 0; g.A_alt = A; g.B_alt = Bt; g.b_stride_alt = 0; g.K_alt = K; return g; }
template <bool SIX> __device__ __forceinline__ const char* gemm_a(const Gemm& g, int br) { if (SIX) { const int i = br >> 1; return (const char*)((br & 1) ? g.A_alt + (size_t)((i > 0) * g.a_off1 + (i > 1) * g.a_off2) : g.A); } return (const char*)(g.A + (size_t)((br > 0) * g.a_off1 + (br > 1) * g.a_off2)); }
template <bool SIX> __device__ __forceinline__ const char* gemm_b(const Gemm& g, int br) { if (SIX) { const int i = br >> 1; return (const char*)((br & 1) ? g.B_alt + (size_t)i * g.b_stride_alt : g.Bt + (size_t)i * g.b_stride); } return (const char*)(g.Bt + (size_t)br * g.b_stride); }
template <bool SIX> __device__ __forceinline__ int gemm_k(const Gemm& g, int br) { if (SIX) { const int i = br >> 1; return (br & 1) ? g.K_alt - (i > 0) * g.k_dec : g.K; } return g.K - (br > 0) * g.k_dec; }

struct StaticOrder {
    static constexpr bool SIX = false;
    int nM, nN, nwg, G, c;
    __host__ __device__ void init(int M, int N, int G_, int c_) { nM = M / BM; nN = N / BM; nwg = nM * nN; G = G_; c = c_; }
    __host__ __device__ __forceinline__ bool next(int i, Unit& u) const {
        const long L = (long)i * G + c; if (L >= nwg) return false;
        int wgid = (int)L; { const int q = nwg / NXCD, r = nwg % NXCD, xcd = wgid % NXCD, off = wgid / NXCD; wgid = (xcd < r ? xcd * (q + 1) : r * (q + 1) + (xcd - r) * q) + off; }
        const int nig = WGM * nN, gid = wgid / nig, fm = gid * WGM, gsz = (nM - fm) < WGM ? (nM - fm) : WGM;
        u.pm = fm + ((wgid % nig) % gsz); u.pn = (wgid % nig) / gsz; u.br = 0; return true;
    }
    __device__ __forceinline__ void a_ready(const Unit&) const {}
    __device__ __forceinline__ void done(const Unit&) const {}
};

struct SixOrder {
    static constexpr bool SIX = true;
    StaticOrder S;
    __device__ __forceinline__ bool next(int ui, Unit& u) const { const int i = ui / 6, br = ui - 6 * i; const bool ok = S.next(i, u); u.br = br; return ok; }
    __device__ __forceinline__ void a_ready(const Unit&) const {}
    __device__ __forceinline__ void done(const Unit&) const {}
};

__device__ __forceinline__ unsigned cvt_pk_bf16(float lo, float hi) { unsigned r; asm volatile("v_cvt_pk_bf16_f32 %0, %1, %2" : "=v"(r) : "v"(lo), "v"(hi)); return r; }
__device__ __forceinline__ float bflo(unsigned w) { return __uint_as_float(w << 16); }
__device__ __forceinline__ float bfhi(unsigned w) { return __uint_as_float(w & 0xffff0000u); }
__device__ __forceinline__ float sigmoidf_fast(float x) { return __builtin_amdgcn_rcpf(1.0f + __builtin_amdgcn_exp2f(-1.4426950408889634f * x)); }
typedef float f32x2 __attribute__((ext_vector_type(2)));
constexpr float NLOG2E = -1.4426950408889634f;
__device__ __forceinline__ f32x2 sig2_scaled(f32x2 x, float k) {
    const f32x2 t = x * k; const f32x2 e = {__builtin_amdgcn_exp2f(t.x), __builtin_amdgcn_exp2f(t.y)}; const f32x2 d = e + 1.0f;
    return (f32x2){__builtin_amdgcn_rcpf(d.x), __builtin_amdgcn_rcpf(d.y)}; }


__device__ __forceinline__ void rstd_to_lds(const float* rstd, int pm, int wid, int lane, PG8_LAS float* dst, int k) {
    if (wid < 4) __builtin_amdgcn_global_load_lds((const unsigned*)(rstd + (size_t)pm * BM + wid * 64 + lane), (PG8_LAS unsigned*)(dst + k * BM + wid * 64), 4, 0, 0);
}
__device__ __forceinline__ u32x4 lanes_to_rows(u32x4 w, int lane) { const int a = ((lane & 3) * 16 + (lane >> 2)) * 4;
    w.x = (unsigned)__builtin_amdgcn_ds_bpermute(a, (int)w.x); w.y = (unsigned)__builtin_amdgcn_ds_bpermute(a, (int)w.y); w.z = (unsigned)__builtin_amdgcn_ds_bpermute(a, (int)w.z); w.w = (unsigned)__builtin_amdgcn_ds_bpermute(a, (int)w.w); return w; }
__device__ __forceinline__ u32x4 rows_to_lanes(u32x4 w, int lane) { const int a = ((lane & 15) * 4 + (lane >> 4)) * 4;
    w.x = (unsigned)__builtin_amdgcn_ds_bpermute(a, (int)w.x); w.y = (unsigned)__builtin_amdgcn_ds_bpermute(a, (int)w.y); w.z = (unsigned)__builtin_amdgcn_ds_bpermute(a, (int)w.z); w.w = (unsigned)__builtin_amdgcn_ds_bpermute(a, (int)w.w); return w; }
struct EpiInProj {
    static constexpr bool PERM = true, AFTER_DRAIN = false, HAS_STATE = true, HAS_PRE = true;
    struct State { int k; };
    bf16_t* H; int ld; size_t sstride; PG8_LAS float* scr;
    const float* rstd; PG8_LAS float* rl;
    __device__ __forceinline__ void pre(const Unit& u, int wr, int wc, int fr, int fq, State& st) const { st.k ^= 1; rstd_to_lds(rstd, u.pm, wr * 4 + wc, fq * 16 + fr, rl, st.k); }
    __device__ __forceinline__ void operator()(const f32x4 (&acc)[2][2][4][2], const Unit& u, int wr, int wc, int fr, int fq, State& st) const {
        const int row0 = u.pm * BM + wr * 64 + fr; const int colt = u.pn * BM;
        const PG8_LAS float* rp = rl + st.k * BM + wr * 64 + fr;
        const int col0 = colt + wc * 32 + 8 * fq;
        const int h0 = 2 * u.pn, h1 = h0 + 1;
        const int md0 = (h0 >= 23 && h0 <= 27) ? 1 : ((h0 >= 38 && h0 <= 42) ? 2 : 0), md1 = (h1 >= 23 && h1 <= 27) ? 1 : ((h1 >= 38 && h1 <= 42) ? 2 : 0);
        if (md0 | md1) {
#pragma unroll
            for (int ai = 0; ai < 2; ++ai)
#pragma unroll
                for (int m = 0; m < 4; ++m)
#pragma unroll
                    for (int bj = 0; bj < 2; ++bj) { const f32x4 v0 = acc[ai][bj][m][0], v1 = acc[ai][bj][m][1];
                        float ss = ((v0[0] * v0[0] + v0[1] * v0[1]) + (v0[2] * v0[2] + v0[3] * v0[3])) + ((v1[0] * v1[0] + v1[1] * v1[1]) + (v1[2] * v1[2] + v1[3] * v1[3]));
                        ss += __builtin_bit_cast(float, __builtin_amdgcn_ds_swizzle(__builtin_bit_cast(int, ss), 0x401F));
                        { auto rr = __builtin_amdgcn_permlane32_swap(__float_as_uint(ss), __float_as_uint(ss), false, false); ss = __uint_as_float(rr[0]) + __uint_as_float(rr[1]); }
                        if (fq == 0) scr[((wr * 64 + ai * HALF + m * 16 + fr) * 2 + bj) * 4 + wc] = ss; }
            asm volatile("s_waitcnt lgkmcnt(0)" ::: "memory"); __builtin_amdgcn_s_barrier(); asm volatile("" ::: "memory");
        }
        const int lane_ = fq * 16 + fr;
        bf16_t* const HT = H + (size_t)(2 * u.pn) * sstride + (size_t)(u.pm * BM + wr * 64 + (lane_ >> 2)) * ld + wc * 32 + 8 * (lane_ & 3);
#pragma unroll
        for (int ai = 0; ai < 2; ++ai)
#pragma unroll
            for (int m = 0; m < 4; ++m) { bf16_t* rowp = HT + (size_t)(ai * HALF + m * 16) * ld;
                const float rs = rp[ai * HALF + m * 16];
#pragma unroll
                for (int bj = 0; bj < 2; ++bj) { const int md = bj ? md1 : md0; float sc = rs;
                    if (md) { const f32x4 p = *(const PG8_LAS f32x4*)(scr + ((wr * 64 + ai * HALF + m * 16 + fr) * 2 + bj) * 4);
                        const float s64 = ((wc < 2) ? (p[0] + p[1]) : (p[2] + p[3])) * (rs * rs), s128 = ((p[0] + p[1]) + (p[2] + p[3])) * (rs * rs);
                        sc = rs * (md == 1 ? __builtin_amdgcn_rsqf(s64 * (1.f / 64.f) + 1e-6f) : __builtin_amdgcn_rsqf(s128 * (1.f / 128.f) + 1e-6f)); }
                    const f32x4 v0 = acc[ai][bj][m][0] * sc, v1 = acc[ai][bj][m][1] * sc;
                    u32x4 w; w.x = cvt_pk_bf16(v0[0], v0[1]); w.y = cvt_pk_bf16(v0[2], v0[3]); w.z = cvt_pk_bf16(v1[0], v1[1]); w.w = cvt_pk_bf16(v1[2], v1[3]);
                    *(u32x4*)(rowp + bj * sstride) = lanes_to_rows(w, lane_); } }
    }
};
struct EpiGateBranch {
    static constexpr bool PERM = true, AFTER_DRAIN = false, HAS_STATE = true, HAS_PRE = true;
    struct State { unsigned q[16]; int k; };
    bf16_t* GS; bf16_t* Y; int ldy;
    const float* rstd; PG8_LAS float* rl;
    __device__ __forceinline__ void pre(const Unit& u, int wr, int wc, int fr, int fq, State& st) const { st.k ^= 1; rstd_to_lds(rstd, u.pm, wr * 4 + wc, fq * 16 + fr, rl, st.k); }
    __device__ __forceinline__ void operator()(const f32x4 (&acc)[2][2][4][2], const Unit& u, int wr, int wc, int fr_, int fq, State& st) const {
        int fr = fr_; asm volatile("" : "+v"(fr));
        u32x4* gs = (u32x4*)GS + (((wr * 4 + wc) * 64) + fq * 16 + fr);
        if ((u.br & 1) == 0) {
#pragma unroll
            for (int ai = 0; ai < 2; ++ai) {
                unsigned q[16];
#pragma unroll
                for (int m = 0; m < 4; ++m) { const float rs = rl[st.k * BM + wr * 64 + ai * HALF + m * 16 + fr];
#pragma unroll
                    for (int bj = 0; bj < 2; ++bj) { const f32x4 v0 = acc[ai][bj][m][0], v1 = acc[ai][bj][m][1]; const float k = rs * NLOG2E;
                        unsigned b[8];
                        { const f32x2 s0 = sig2_scaled(v0.lo, k) * 255.f + 0.5f, s1 = sig2_scaled(v0.hi, k) * 255.f + 0.5f, s2 = sig2_scaled(v1.lo, k) * 255.f + 0.5f, s3 = sig2_scaled(v1.hi, k) * 255.f + 0.5f;
                          b[0] = (unsigned)s0.x; b[1] = (unsigned)s0.y; b[2] = (unsigned)s1.x; b[3] = (unsigned)s1.y; b[4] = (unsigned)s2.x; b[5] = (unsigned)s2.y; b[6] = (unsigned)s3.x; b[7] = (unsigned)s3.y; }
                        q[(m * 2 + bj) * 2 + 0] = (b[0] | (b[1] << 8)) | ((b[2] << 16) | (b[3] << 24));
                        q[(m * 2 + bj) * 2 + 1] = (b[4] | (b[5] << 8)) | ((b[6] << 16) | (b[7] << 24)); } }
                if (ai == 0) {
#pragma unroll
                    for (int i = 0; i < 16; ++i) st.q[i] = q[i];
                } else {
#pragma unroll
                    for (int p = 0; p < 4; ++p) gs[p * 512] = (u32x4){q[4 * p], q[4 * p + 1], q[4 * p + 2], q[4 * p + 3]};
                }
            }
        } else {
            const int lane_ = fq * 16 + fr;
            const int row0 = u.pm * BM + wr * 64 + (lane_ >> 2); const int col0 = u.pn * BM + wc * 32 + 8 * (lane_ & 3);
            const bool first = u.br == 1;
            constexpr float Q = 1.f / 255.f;
#pragma unroll
            for (int ai = 0; ai < 2; ++ai) {
                u32x4 y[4][2]; unsigned q[16];
                if (ai == 0) {
#pragma unroll
                    for (int i = 0; i < 16; ++i) q[i] = st.q[i];
                } else {
#pragma unroll
                    for (int p = 0; p < 4; ++p) { const u32x4 t = gs[p * 512]; q[4 * p] = t.x; q[4 * p + 1] = t.y; q[4 * p + 2] = t.z; q[4 * p + 3] = t.w; }
                }
#pragma unroll
                for (int m = 0; m < 4; ++m)
#pragma unroll
                    for (int bj = 0; bj < 2; ++bj) { const size_t r = (size_t)(row0 + ai * HALF + m * 16);
                        if (!first) y[m][bj] = *(const u32x4*)(Y + r * ldy + col0 + bj * HALF); else y[m][bj] = (u32x4){0u, 0u, 0u, 0u}; }
                if (!first) {
#pragma unroll
                    for (int m = 0; m < 4; ++m)
#pragma unroll
                        for (int bj = 0; bj < 2; ++bj) y[m][bj] = rows_to_lanes(y[m][bj], lane_); }
#pragma unroll
                for (int m = 0; m < 4; ++m)
#pragma unroll
                    for (int bj = 0; bj < 2; ++bj) { const size_t r = (size_t)(row0 + ai * HALF + m * 16); const f32x4 v0 = acc[ai][bj][m][0], v1 = acc[ai][bj][m][1]; const u32x4 yy = y[m][bj];
                        const unsigned q0 = q[(m * 2 + bj) * 2 + 0], q1 = q[(m * 2 + bj) * 2 + 1];
                        const f32x2 a0 = ((f32x2){(float)(q0 & 255u), (float)((q0 >> 8) & 255u)} * v0.lo) * Q + (f32x2){bflo(yy.x), bfhi(yy.x)}, a1 = ((f32x2){(float)((q0 >> 16) & 255u), (float)(q0 >> 24)} * v0.hi) * Q + (f32x2){bflo(yy.y), bfhi(yy.y)};
                        const f32x2 a2 = ((f32x2){(float)(q1 & 255u), (float)((q1 >> 8) & 255u)} * v1.lo) * Q + (f32x2){bflo(yy.z), bfhi(yy.z)}, a3 = ((f32x2){(float)((q1 >> 16) & 255u), (float)(q1 >> 24)} * v1.hi) * Q + (f32x2){bflo(yy.w), bfhi(yy.w)};
                        u32x4 w; w.x = cvt_pk_bf16(a0.x, a0.y); w.y = cvt_pk_bf16(a1.x, a1.y); w.z = cvt_pk_bf16(a2.x, a2.y); w.w = cvt_pk_bf16(a3.x, a3.y);
                        *(u32x4*)(Y + r * ldy + col0 + bj * HALF) = lanes_to_rows(w, lane_); }
            }
        }
    }
};
struct EpiResid {
    static constexpr bool PERM = true, AFTER_DRAIN = false, HAS_STATE = false, HAS_PRE = false;
    struct State {};
    const bf16_t* base; bf16_t* outb; float* outf; int ldc; float* ssq; PG8_LAS float* scr;
    __device__ __forceinline__ void operator()(const f32x4 (&acc)[2][2][4][2], const Unit& u, int wr, int wc, int fr, int fq) const {
        const int lane_ = fq * 16 + fr;
        const int row0T = u.pm * BM + wr * 64 + (lane_ >> 2); const int col0T = u.pn * BM + wc * 32 + 8 * (lane_ & 3);
        float ss[2][4];
#pragma unroll
        for (int ai = 0; ai < 2; ++ai) {
            u32x4 b[4][2];
#pragma unroll
            for (int m = 0; m < 4; ++m) { const size_t offT = (size_t)(row0T + ai * HALF + m * 16) * ldc + col0T;
#pragma unroll
                for (int bj = 0; bj < 2; ++bj) b[m][bj] = *(const u32x4*)(base + offT + bj * HALF); }
#pragma unroll
            for (int m = 0; m < 4; ++m)
#pragma unroll
                for (int bj = 0; bj < 2; ++bj) b[m][bj] = rows_to_lanes(b[m][bj], lane_);
#pragma unroll
            for (int m = 0; m < 4; ++m) { const size_t offT = (size_t)(row0T + ai * HALF + m * 16) * ldc + col0T; float sq = 0.f;
#pragma unroll
                for (int bj = 0; bj < 2; ++bj) { const u32x4 bb = b[m][bj]; const f32x4 v0 = acc[ai][bj][m][0], v1 = acc[ai][bj][m][1];
                    const f32x4 o0 = (f32x4){bflo(bb.x), bfhi(bb.x), bflo(bb.y), bfhi(bb.y)} + v0, o1 = (f32x4){bflo(bb.z), bfhi(bb.z), bflo(bb.w), bfhi(bb.w)} + v1;
                    { const f32x4 s4 = o0 * o0 + o1 * o1; sq += (s4[0] + s4[1]) + (s4[2] + s4[3]); }
                    if (outf) { const u32x4 t0 = lanes_to_rows(__builtin_bit_cast(u32x4, o0), lane_), t1 = lanes_to_rows(__builtin_bit_cast(u32x4, o1), lane_);
                        *(u32x4*)(outf + offT + bj * HALF) = t0; *(u32x4*)(outf + offT + bj * HALF + 4) = t1; }
                    else { u32x4 w; w.x = cvt_pk_bf16(o0[0], o0[1]); w.y = cvt_pk_bf16(o0[2], o0[3]); w.z = cvt_pk_bf16(o1[0], o1[1]); w.w = cvt_pk_bf16(o1[2], o1[3]); *(u32x4*)(outb + offT + bj * HALF) = lanes_to_rows(w, lane_); } }
                ss[ai][m] = sq; }
        }
        if (ssq) {
#pragma unroll
            for (int ai = 0; ai < 2; ++ai)
#pragma unroll
                for (int m = 0; m < 4; ++m) { float t = ss[ai][m];
                    t += __builtin_bit_cast(float, __builtin_amdgcn_ds_swizzle(__builtin_bit_cast(int, t), 0x401F));
                    { auto rr = __builtin_amdgcn_permlane32_swap(__float_as_uint(t), __float_as_uint(t), false, false); t = __uint_as_float(rr[0]) + __uint_as_float(rr[1]); }
                    if (fq == 0) scr[(wr * 64 + ai * HALF + m * 16 + fr) * 4 + wc] = t; }
            asm volatile("s_waitcnt lgkmcnt(0)" ::: "memory"); __builtin_amdgcn_s_barrier(); asm volatile("" ::: "memory");
            const int t_ = (wr * 4 + wc) * 64 + fq * 16 + fr;
            if (t_ < BM) { const f32x4 p = *(const PG8_LAS f32x4*)(scr + t_ * 4); ssq[(size_t)(u.pm * BM + t_) * 8 + u.pn] = (p[0] + p[1]) + (p[2] + p[3]); }
        }
    }
};
struct EpiSwiglu {
    static constexpr bool PERM = true, AFTER_DRAIN = false, HAS_STATE = true, HAS_PRE = true;
    struct State { f32x4 p0, p1; };
    bf16_t* O; int ldo; const float* ssq; PG8_LAS float* scr; float inv_n, eps;
    __device__ __forceinline__ void pre(const Unit& u, int wr, int wc, int fr, int fq, State& st) const {
        const int t_ = ((wr * 4 + wc) * 64 + fq * 16 + fr) & (BM - 1);
        const f32x4* p = (const f32x4*)(ssq + (size_t)(u.pm * BM + t_) * 8); st.p0 = p[0]; st.p1 = p[1];
    }
    __device__ __forceinline__ void operator()(const f32x4 (&acc)[2][2][4][2], const Unit& u, int wr, int wc, int fr, int fq, State& st) const {
        { const int t_ = (wr * 4 + wc) * 64 + fq * 16 + fr;
          const float sum = ((st.p0[0] + st.p0[1]) + (st.p0[2] + st.p0[3])) + ((st.p1[0] + st.p1[1]) + (st.p1[2] + st.p1[3]));
          if (t_ < BM) scr[t_] = __builtin_amdgcn_rsqf(sum * inv_n + eps);
          asm volatile("s_waitcnt lgkmcnt(0)" ::: "memory"); __builtin_amdgcn_s_barrier(); asm volatile("" ::: "memory"); }
        const int lane_ = fq * 16 + fr;
        const int row0 = u.pm * BM + wr * 64 + (lane_ >> 2); const int col0 = u.pn * HALF + wc * 32 + 8 * (lane_ & 3);
#pragma unroll
        for (int ai = 0; ai < 2; ++ai)
#pragma unroll
            for (int m = 0; m < 4; ++m) { bf16_t* rowp = O + (size_t)(row0 + ai * HALF + m * 16) * ldo + col0;
                const float rs = scr[wr * 64 + ai * HALF + m * 16 + fr];
                const float k = rs * NLOG2E, rs2 = rs * rs;
                const f32x4 g0 = acc[ai][0][m][0], g1 = acc[ai][0][m][1], u0 = acc[ai][1][m][0], u1 = acc[ai][1][m][1];
                const f32x2 o0 = (g0.lo * u0.lo) * (sig2_scaled(g0.lo, k) * rs2), o1 = (g0.hi * u0.hi) * (sig2_scaled(g0.hi, k) * rs2), o2 = (g1.lo * u1.lo) * (sig2_scaled(g1.lo, k) * rs2), o3 = (g1.hi * u1.hi) * (sig2_scaled(g1.hi, k) * rs2);
                u32x4 w; w.x = cvt_pk_bf16(o0.x, o0.y); w.y = cvt_pk_bf16(o1.x, o1.y); w.z = cvt_pk_bf16(o2.x, o2.y); w.w = cvt_pk_bf16(o3.x, o3.y);
                *(u32x4*)rowp = lanes_to_rows(w, lane_); }
    }
};

template <class Epi, class Sched, bool ALIGN_EPI = false, bool SP2 = false>
__device__ __forceinline__ void gemm_phase(PG8_LAS unsigned char* lds, const Gemm g, const Sched& S, const Epi& E) {
    int tid_ = threadIdx.x; asm volatile("" : "+v"(tid_));
    const int tid = tid_, wid = __builtin_amdgcn_readfirstlane(tid >> 6), lane = tid & 63, wr = wid >> 2, wc = wid & 3, fr = lane & 15, fq = lane >> 4;
    unsigned voffA[2], voffB[2];
#pragma unroll
    for (int i = 0; i < 2; ++i) { int R, C; stage_rc(tid * 16 + i * 8192, R, C); const int Rb = Epi::PERM ? ((R & ~31) + perm32(R & 31)) : R;
        voffA[i] = (unsigned)(R * g.lda + C) * 2u; voffB[i] = (unsigned)(Rb * g.ldb + C) * 2u; }
    const size_t kstep = (size_t)(BK * 2);
    const size_t hstepA = (size_t)HALF * g.lda * 2, hstepB = (size_t)HALF * g.ldb * 2;
    const size_t tstepA = 2 * hstepA, tstepB = 2 * hstepB;
    const unsigned ldsw = (unsigned)wid * 1024u;
    const int aoff = lds_byte(wr * 64 + fr, fq * 8), boff = lds_byte(wc * 32 + fr, fq * 8);
#define PG8_SA(b, h) (((b) * 2 + (h)) * HTB)
#define PG8_SB(b, h) ((4 + (b) * 2 + (h)) * HTB)
#define PG8_STAGE(bufoff, gbase, voff) do { _Pragma("unroll") for (int _i = 0; _i < 2; ++_i) \
        __builtin_amdgcn_global_load_lds((const unsigned*)((const char*)(gbase) + (voff)[_i]), (PG8_LAS unsigned*)(lds + (bufoff) + ldsw + _i * 8192), 16, 0, 0); } while (0)
#define PG8_LDA(dst, b, h) do { _Pragma("unroll") for (int m = 0; m < 4; ++m) _Pragma("unroll") for (int k = 0; k < 2; ++k) dst[m][k] = *(const PG8_LAS bf16x8*)(lds + PG8_SA(b, h) + (aoff ^ (k * 64)) + m * 2048); } while (0)
#define PG8_LDB(dst, b, h) do { _Pragma("unroll") for (int n = 0; n < 2; ++n) _Pragma("unroll") for (int k = 0; k < 2; ++k) dst[n][k] = *(const PG8_LAS bf16x8*)(lds + PG8_SB(b, h) + (boff ^ (k * 64)) + n * 2048); } while (0)
#define PG8_MMA(ai, bj, At, Bt) do { __builtin_amdgcn_s_setprio(1); _Pragma("unroll") for (int m = 0; m < 4; ++m) _Pragma("unroll") for (int n = 0; n < 2; ++n) _Pragma("unroll") for (int k = 0; k < 2; ++k) \
        acc[ai][bj][m][n] = __builtin_amdgcn_mfma_f32_16x16x32_bf16(Bt[n][k], At[m][k], acc[ai][bj][m][n], 0, 0, 0); __builtin_amdgcn_s_setprio(0); } while (0)
#define PG8_WAIT_V(n) asm volatile("s_waitcnt vmcnt(" #n ")" ::: "memory")
#define PG8_WAIT_L(n) asm volatile("s_waitcnt lgkmcnt(" #n ")" ::: "memory")
#define PG8_BAR __builtin_amdgcn_s_barrier()
#define PG8_SCHED __builtin_amdgcn_sched_barrier(0)
    Unit cur, nxt; int ui = 0;
    if (!S.next(0, cur)) return;
    f32x4 acc[2][2][4][2];
#pragma unroll
    for (int a = 0; a < 2; ++a)
#pragma unroll
        for (int b = 0; b < 2; ++b)
#pragma unroll
            for (int m = 0; m < 4; ++m)
#pragma unroll
                for (int n = 0; n < 2; ++n) acc[a][b][m][n] = (f32x4){0.f, 0.f, 0.f, 0.f};
    bf16x8 At[4][2], B0[2][2], B1[2][2];
    typename Epi::State est{};
    const char* cA = gemm_a<Sched::SIX>(g, cur.br) + (size_t)cur.pm * tstepA; const char* cB = gemm_b<Sched::SIX>(g, cur.br) + (size_t)cur.pn * tstepB;
    S.a_ready(cur);
    if constexpr (SP2) {
        PG8_STAGE(PG8_SB(0, 0), cB, voffB); PG8_STAGE(PG8_SB(0, 1), cB + hstepB, voffB); PG8_STAGE(PG8_SA(0, 0), cA, voffA); PG8_STAGE(PG8_SA(0, 1), cA + hstepA, voffA);
        if (wr == 1) PG8_BAR;
        PG8_WAIT_V(2); PG8_BAR;
        PG8_STAGE(PG8_SB(1, 0), cB + kstep, voffB); PG8_STAGE(PG8_SA(1, 0), cA + kstep, voffA); PG8_STAGE(PG8_SB(1, 1), cB + hstepB + kstep, voffB);
        PG8_WAIT_V(6); PG8_BAR;
    } else {
        PG8_STAGE(PG8_SB(0, 0), cB, voffB); PG8_STAGE(PG8_SA(0, 0), cA, voffA); PG8_STAGE(PG8_SB(0, 1), cB + hstepB, voffB); PG8_STAGE(PG8_SA(0, 1), cA + hstepA, voffA);
        if (wr == 1) PG8_BAR;
        PG8_WAIT_V(4); PG8_BAR;
        PG8_STAGE(PG8_SB(1, 0), cB + kstep, voffB); PG8_STAGE(PG8_SA(1, 0), cA + kstep, voffA); PG8_STAGE(PG8_SB(1, 1), cB + hstepB + kstep, voffB);
        PG8_WAIT_V(6); PG8_BAR;
    }
    for (;;) {
        const bool has_next = S.next(ui + 1, nxt);
        const char* nA = has_next ? gemm_a<Sched::SIX>(g, nxt.br) + (size_t)nxt.pm * tstepA : cA; const char* nB = has_next ? gemm_b<Sched::SIX>(g, nxt.br) + (size_t)nxt.pn * tstepB : cB;
        const int nt = gemm_k<Sched::SIX>(g, cur.br) / BK;
        if constexpr (Epi::HAS_PRE) { int t2 = threadIdx.x; asm volatile("" : "+v"(t2)); E.pre(cur, wr, wc, t2 & 15, (t2 >> 4) & 3, est); }
        for (int t = 0; t < nt; t += 2) {
            const bool last = (t == nt - 2);
            const char* a1 = cA + (size_t)(t + 1) * kstep;
            const char* a2 = last ? nA : cA + (size_t)(t + 2) * kstep; const char* b2 = last ? nB : cB + (size_t)(t + 2) * kstep;
            const char* a3 = a2 + kstep; const char* b3 = b2 + kstep;
            if (last && has_next) S.a_ready(nxt);
            if constexpr (SP2) {
            PG8_LDB(B0, 0, 0); PG8_LDB(B1, 0, 1); PG8_SCHED; PG8_LDA(At, 0, 0); PG8_STAGE(PG8_SA(1, 1), a1 + hstepA, voffA);
            PG8_WAIT_V(8); PG8_WAIT_L(0); PG8_BAR; PG8_MMA(0, 0, At, B0); PG8_MMA(0, 1, At, B1); PG8_BAR; PG8_SCHED;
            PG8_LDA(At, 0, 1); PG8_STAGE(PG8_SB(0, 0), b2, voffB); PG8_STAGE(PG8_SB(0, 1), b2 + hstepB, voffB); PG8_STAGE(PG8_SA(0, 0), a2, voffA);
            PG8_WAIT_V(8); PG8_WAIT_L(0); PG8_BAR; PG8_MMA(1, 0, At, B0); PG8_MMA(1, 1, At, B1); PG8_BAR; PG8_SCHED;
            PG8_LDB(B0, 1, 0); PG8_LDB(B1, 1, 1); PG8_SCHED; PG8_LDA(At, 1, 0); PG8_STAGE(PG8_SA(0, 1), a2 + hstepA, voffA);
            PG8_WAIT_V(8); PG8_WAIT_L(0); PG8_BAR; PG8_MMA(0, 0, At, B0); PG8_MMA(0, 1, At, B1); PG8_BAR; PG8_SCHED;
            PG8_LDA(At, 1, 1); PG8_STAGE(PG8_SB(1, 0), b3, voffB); PG8_STAGE(PG8_SB(1, 1), b3 + hstepB, voffB); PG8_STAGE(PG8_SA(1, 0), a3, voffA);
            PG8_WAIT_V(8); PG8_WAIT_L(0); PG8_BAR; PG8_MMA(1, 0, At, B0); PG8_MMA(1, 1, At, B1); PG8_BAR; PG8_SCHED;
            } else {
            PG8_LDB(B0, 0, 0); PG8_SCHED; PG8_LDA(At, 0, 0); PG8_STAGE(PG8_SA(1, 1), a1 + hstepA, voffA);
            PG8_WAIT_L(8); PG8_BAR; PG8_WAIT_L(0); PG8_MMA(0, 0, At, B0); PG8_BAR; PG8_SCHED;
            PG8_LDB(B1, 0, 1); PG8_STAGE(PG8_SB(0, 0), b2, voffB);
            PG8_BAR; PG8_WAIT_L(0); PG8_MMA(0, 1, At, B1); PG8_BAR;
            PG8_LDA(At, 0, 1); PG8_STAGE(PG8_SA(0, 0), a2, voffA);
            PG8_BAR; PG8_WAIT_L(0); PG8_MMA(1, 0, At, B0); PG8_BAR; PG8_SCHED;
            PG8_STAGE(PG8_SB(0, 1), b2 + hstepB, voffB);
            PG8_WAIT_V(6); PG8_BAR; PG8_MMA(1, 1, At, B1); PG8_BAR;
            PG8_LDB(B0, 1, 0); PG8_SCHED; PG8_LDA(At, 1, 0); PG8_STAGE(PG8_SA(0, 1), a2 + hstepA, voffA);
            PG8_WAIT_L(8); PG8_BAR; PG8_WAIT_L(0); PG8_MMA(0, 0, At, B0); PG8_BAR; PG8_SCHED;
            PG8_LDB(B1, 1, 1); PG8_STAGE(PG8_SB(1, 0), b3, voffB);
            PG8_BAR; PG8_WAIT_L(0); PG8_MMA(0, 1, At, B1); PG8_BAR;
            PG8_LDA(At, 1, 1); PG8_STAGE(PG8_SA(1, 0), a3, voffA);
            PG8_BAR; PG8_WAIT_L(0); PG8_MMA(1, 0, At, B0); PG8_BAR; PG8_SCHED;
            PG8_STAGE(PG8_SB(1, 1), b3 + hstepB, voffB);
            PG8_WAIT_V(6); PG8_BAR; PG8_MMA(1, 1, At, B1); PG8_BAR;
            }
        }
        if constexpr (ALIGN_EPI) { if (wr == 0) PG8_BAR; }
        { int t2 = threadIdx.x; asm volatile("" : "+v"(t2)); const int fr2 = t2 & 15, fq2 = (t2 >> 4) & 3;
          if constexpr (Epi::HAS_STATE) { E(acc, cur, wr, wc, fr2, fq2, est); S.done(cur); } else if constexpr (!Epi::AFTER_DRAIN) { E(acc, cur, wr, wc, fr2, fq2); S.done(cur); } }
        if (!has_next) break;
#pragma unroll
        for (int a = 0; a < 2; ++a)
#pragma unroll
            for (int b = 0; b < 2; ++b)
#pragma unroll
                for (int m = 0; m < 4; ++m)
#pragma unroll
                    for (int n = 0; n < 2; ++n) acc[a][b][m][n] = (f32x4){0.f, 0.f, 0.f, 0.f};
        cur = nxt; cA = nA; cB = nB; ++ui;
        if constexpr (ALIGN_EPI) { if (wr == 1) PG8_BAR; }
    }
    PG8_WAIT_V(0);
    if constexpr (!ALIGN_EPI) { if (wr == 0) PG8_BAR; }
    PG8_BAR;
#undef PG8_SA
#undef PG8_SB
#undef PG8_STAGE
#undef PG8_LDA
#undef PG8_LDB
#undef PG8_MMA
#undef PG8_WAIT_V
#undef PG8_WAIT_L
#undef PG8_BAR
#undef PG8_SCHED
}
}

constexpr int NWAVES = 8;
constexpr int BATCH = 16, SEQ = 2048, DM = 2048, DEPTH = 4;
constexpr int M = BATCH * SEQ;
constexpr int HD = 128, H_SB = 6, H_DIFF = 5, H_FOX = 5;
constexpr int D_SB = 768, D_DIFF = 640, D_FOX = 640;
constexpr int D_QKV = 6144, D_IN = 6149, D_FF = 5632;
constexpr int NGU = 2 * D_FF;
constexpr int QA = 0, KA = 768, VA = 1536, QB_ = 2304, KB_ = 2944, VB_ = 3584, QC = 4224, KC = 4864, VC = 5504;
constexpr int OA = 0, OB = 768, OC = 1408;
constexpr int HLD = 128;
__host__ __device__ constexpr size_t hslot(int col) { return (size_t)(col / 128) * ((size_t)BATCH * SEQ * 128); }
constexpr float EPS = 1e-6f;
constexpr int NPH = 8;
constexpr int NSTEP = DEPTH * NPH;

constexpr size_t MiB = 1u << 20;
constexpr size_t WS_CTL = 0, CTL_ZERO_BYTES = 2 * MiB;
constexpr size_t WS_WIG = 2 * MiB;
constexpr size_t WS_WBR = WS_WIG + 48 * MiB;
constexpr size_t WS_WOUT = WS_WBR + 24 * MiB;
constexpr size_t WS_WGU = WS_WOUT + 8 * MiB;
constexpr size_t WS_WDN = WS_WGU + 44 * MiB;
constexpr size_t WS_LOGF = WS_WDN + 22 * MiB;
constexpr size_t WS_CUM = WS_LOGF + 1 * MiB;
constexpr size_t WS_XN = WS_CUM + 1 * MiB;
constexpr size_t WS_H = WS_XN + 128 * MiB;
constexpr size_t WS_G = WS_H + 384 * MiB;
constexpr size_t WS_O = WS_G + 384 * MiB;
constexpr size_t WS_STASH = WS_O + 128 * MiB;
constexpr size_t WS_END = WS_STASH + 32 * MiB;
constexpr size_t WS_XB = WS_G + 128 * MiB;
constexpr size_t WS_SSQ = WS_G + 256 * MiB;
constexpr size_t WS_RSTD = WS_SSQ + 1 * MiB;
constexpr size_t WS_Y = WS_H;
constexpr size_t WS_HFF = WS_H + 128 * MiB;
static_assert(WS_HFF + (size_t)M * D_FF * 2 <= WS_XB && WS_XB + (size_t)M * DM * 2 <= WS_SSQ && WS_SSQ + (size_t)M * 8 * 4 <= WS_RSTD && WS_RSTD + (size_t)M * 4 <= WS_O, "HFF overlay / residual stream / row statistics");
constexpr int CW_TMO = 0, CW_CODE = 1;
constexpr int CW_Q = 8192;
constexpr int CW_BAR = 4096;

constexpr int RING_OFF = 0, RING_BYTES = 131072;
constexpr int LDSCTL_OFF = RING_BYTES, MISC_OFF = LDSCTL_OFF + 320;
constexpr int LDS_BYTES = 147456;

#define GAS __attribute__((address_space(1)))
#define LAS __attribute__((address_space(3)))
typedef unsigned short bf16;
typedef unsigned v4u __attribute__((ext_vector_type(4)));
typedef unsigned v2u __attribute__((ext_vector_type(2)));
typedef float f32x4 __attribute__((ext_vector_type(4)));
typedef GAS unsigned gu32;
#define RLX_AGENT __ATOMIC_RELAXED, __HIP_MEMORY_SCOPE_AGENT
#define LDS_WAIT() asm volatile("s_waitcnt lgkmcnt(0)" ::: "memory")
#define VM_WAIT() asm volatile("s_waitcnt vmcnt(0)" ::: "memory")
__device__ __forceinline__ unsigned f2bf(float f) { unsigned u = __builtin_bit_cast(unsigned, f); return (u + 0x7fffu + ((u >> 16) & 1u)) >> 16; }
__device__ __forceinline__ unsigned pk2(float lo, float hi) { return f2bf(lo) | (f2bf(hi) << 16); }
__device__ __forceinline__ float bflo(unsigned w) { return __uint_as_float(w << 16); }
__device__ __forceinline__ float bfhi(unsigned w) { return __uint_as_float(w & 0xffff0000u); }

#define XB_TMO      128
#define XB_XCNT(j)  (256  + 64 * (j))
#define XB_XSUB(j)  (1280 + 64 * (j))
#define XB_XGEN(j)  (2304 + 64 * (j))
#define XB_TOP      3328
#define XB_TOPGEN   3392
#define XCD_BAR_WORDS 3456
#define XB_SPIN_CAP (1u << 18)
__device__ __forceinline__ unsigned xb_ld(unsigned* p)              { return __hip_atomic_load(p, __ATOMIC_RELAXED, __HIP_MEMORY_SCOPE_AGENT); }
__device__ __forceinline__ unsigned xb_add(unsigned* p, unsigned v) { return __hip_atomic_fetch_add(p, v, __ATOMIC_RELAXED, __HIP_MEMORY_SCOPE_AGENT); }
__device__ __forceinline__ unsigned xb_xcc_id() { return (unsigned)__builtin_amdgcn_s_getreg((3 << 11) | 20) & 0xFu; }
#define XB_SPIN(cond, bar) do { unsigned _sp = 0; while (cond) { __builtin_amdgcn_s_sleep(1); \
    if ((++_sp & 255u) == 0u) { if (xb_ld(&(bar)[XB_TMO])) break; if (_sp > XB_SPIN_CAP) { atomicAdd(&(bar)[XB_TMO], 1u); break; } } } } while (0)
struct XcdBarrier { unsigned* bar; unsigned x; volatile LAS unsigned* st; };
__device__ __forceinline__ XcdBarrier xcd_barrier_post(unsigned* bar, volatile LAS unsigned* st) {
    XcdBarrier b; b.bar = bar; b.x = xb_xcc_id(); b.st = st;
    if (threadIdx.x == 0) (void)xb_add(&bar[XB_XCNT(b.x)], 1u);
    return b;
}
__device__ __forceinline__ void xcd_barrier_complete(unsigned* bar, unsigned x, unsigned& nloc, unsigned& nx) {
    const unsigned G = gridDim.x * gridDim.y * gridDim.z;
    unsigned sum, cnt, mine, sp = 0u;
    for (;;) {
        sum = 0u; cnt = 0u; mine = 0u;
#pragma unroll
        for (unsigned j = 0; j < 16; ++j) { const unsigned c = xb_ld(&bar[XB_XCNT(j)]); sum += c; cnt += (c > 0u) ? 1u : 0u; mine = (j == x) ? c : mine; }
        if (sum == G) break;
        __builtin_amdgcn_s_sleep(1);
        if ((++sp & 255u) == 0u) { if (xb_ld(&bar[XB_TMO])) break; if (sp > XB_SPIN_CAP) { atomicAdd(&bar[XB_TMO], 1u); break; } }
    }
    nloc = mine > 0u ? mine : 1u; nx = cnt > 0u ? cnt : 1u;
}
__device__ __forceinline__ void xcd_barrier(const XcdBarrier& b) {
    asm volatile("s_waitcnt vmcnt(0)" ::: "memory");
    __syncthreads();
    if (threadIdx.x == 0) {
        unsigned* bar = b.bar;
        __builtin_amdgcn_s_waitcnt(0);
        unsigned nloc = b.st[0], nx = b.st[1];
        if (nloc == 0u) { xcd_barrier_complete(bar, b.x, nloc, nx); b.st[0] = nloc; b.st[1] = nx; }
        const unsigned old = xb_add(&bar[XB_XSUB(b.x)], 1u);
        const unsigned gen = old / nloc;
        if (old + 1u == (gen + 1u) * nloc) {
            __builtin_amdgcn_fence(__ATOMIC_RELEASE, "agent");
            asm volatile("s_waitcnt vmcnt(0)" ::: "memory");
            const unsigned og = xb_add(&bar[XB_TOP], 1u);
            const unsigned tg = og / nx;
            if (og + 1u == (tg + 1u) * nx) xb_add(&bar[XB_TOPGEN], 1u);
            else XB_SPIN(xb_ld(&bar[XB_TOPGEN]) == tg, bar);
            __builtin_amdgcn_fence(__ATOMIC_ACQUIRE, "agent");
            xb_add(&bar[XB_XGEN(b.x)], 1u);
            asm volatile("s_waitcnt vmcnt(0)" ::: "memory");
        } else {
            XB_SPIN(xb_ld(&bar[XB_XGEN(b.x)]) == gen, bar);
            __builtin_amdgcn_fence(__ATOMIC_ACQUIRE, "agent");
            asm volatile("s_waitcnt vmcnt(0)" ::: "memory");
        }
    }
    __syncthreads();
}

__device__ __forceinline__ float wave_sum(float v) {
#pragma unroll
    for (int o = 1; o < 64; o <<= 1) v += __shfl_xor(v, o);
    return v;
}
__device__ __forceinline__ float wave_max(float v) {
#pragma unroll
    for (int o = 1; o < 64; o <<= 1) v = fmaxf(v, __shfl_xor(v, o));
    return v;
}
__device__ __forceinline__ float softplusf(float z) { return fmaxf(z, 0.f) + log1pf(__expf(-fabsf(z))); }
__device__ __forceinline__ float logsigmoidf(float z) { return fminf(z, 0.f) - __logf(1.f + __expf(-fabsf(z))); }

__device__ __forceinline__ void transpose_item(const float* W, int ld, int K, bf16* WT, int k0, int n0, int drow0, LAS float* scr, int lane, const float* ks) {
#pragma unroll 8
    for (int i = 0; i < 32; ++i) { const int kk = 2 * i + (lane >> 5); scr[kk * 33 + (lane & 31)] = W[(size_t)(k0 + kk) * ld + n0 + (lane & 31)]; }
    LDS_WAIT(); asm volatile("" ::: "memory");
    const int c = lane & 7;
    f32x4 k0v = {1.f, 1.f, 1.f, 1.f}, k1v = k0v;
    if (ks) { k0v = *(const f32x4*)(ks + k0 + 8 * c); k1v = *(const f32x4*)(ks + k0 + 8 * c + 4); }
#pragma unroll
    for (int j = 0; j < 4; ++j) { const int n = (lane >> 3) + 8 * j; const LAS float* s = scr + (8 * c) * 33 + n;
        v4u o; o.x = pk2(s[0 * 33] * k0v.x, s[1 * 33] * k0v.y); o.y = pk2(s[2 * 33] * k0v.z, s[3 * 33] * k0v.w); o.z = pk2(s[4 * 33] * k1v.x, s[5 * 33] * k1v.y); o.w = pk2(s[6 * 33] * k1v.z, s[7 * 33] * k1v.w);
        *(GAS v4u*)(WT + (size_t)(drow0 + n) * K + k0 + 8 * c) = o; }
    LDS_WAIT(); asm volatile("" ::: "memory");
}

struct Args { const float* in[22]; float* out; unsigned char* ws; int s_lo, s_hi, li, pad; };

__device__ __forceinline__ void phase_convert(const Args& a, int l, LAS unsigned char* lds, int wave, int lane, int vcu, int G) {
    LAS float* scr = (LAS float*)(lds + RING_OFF + wave * 16384);
    const int gw = vcu * NWAVES + wave, NGW = G * NWAVES;
    unsigned char* ws = a.ws;
    bf16* Wig = (bf16*)(ws + WS_WIG); bf16* Wbr = (bf16*)(ws + WS_WBR); bf16* Wout = (bf16*)(ws + WS_WOUT); bf16* Wgu = (bf16*)(ws + WS_WGU); bf16* Wdn = (bf16*)(ws + WS_WDN);
    const float* w_in = a.in[2] + (size_t)l * DM * D_IN;
    const float* w_gate = a.in[16] + (size_t)l * DM * D_QKV;
    const float* w_bsb = a.in[13] + (size_t)l * D_SB * DM;
    const float* w_bdf = a.in[14] + (size_t)l * D_DIFF * DM;
    const float* w_bfx = a.in[15] + (size_t)l * D_FOX * DM;
    const float* w_out = a.in[17] + (size_t)l * DM * DM;
    const float* w_fg = a.in[19] + (size_t)l * DM * D_FF;
    const float* w_fu = a.in[20] + (size_t)l * DM * D_FF;
    const float* w_fd = a.in[21] + (size_t)l * D_FF * DM;
    constexpr int I_IN = (DM / 64) * (D_QKV / 32);
    constexpr int I_SB = (D_SB / 64) * (DM / 32);
    constexpr int I_DF = (D_DIFF / 64) * (DM / 32);
    constexpr int I_OUT = (DM / 64) * (DM / 32);
    constexpr int I_FF = (DM / 64) * (D_FF / 32);
    constexpr int I_DN = (D_FF / 64) * (DM / 32);
    constexpr int NITEMS = 2 * I_IN + I_SB + 2 * I_DF + I_OUT + 2 * I_FF + I_DN;
    for (int it = gw; it < NITEMS; it += NGW) {
        int r = it; const float* W; int ld, K, N, mode = 0, ldt = 0, nm = 0; bf16* WT;
        if (r < I_IN) { W = w_in; ld = D_IN; K = DM; N = D_QKV; WT = Wig; nm = 1; }
        else if ((r -= I_IN) < I_IN) { W = w_gate; ld = D_QKV; K = DM; N = D_QKV; WT = Wig + (size_t)D_QKV * DM; nm = 1; }
        else if ((r -= I_IN) < I_SB) { W = w_bsb; ld = DM; K = D_SB; N = DM; WT = Wbr; ldt = DM; }
        else if ((r -= I_SB) < I_DF) { W = w_bdf; ld = DM; K = D_DIFF; N = DM; WT = Wbr + (size_t)DM * DM; ldt = DM; }
        else if ((r -= I_DF) < I_DF) { W = w_bfx; ld = DM; K = D_FOX; N = DM; WT = Wbr + (size_t)2 * DM * DM; ldt = DM; }
        else if ((r -= I_DF) < I_OUT) { W = w_out; ld = DM; K = DM; N = DM; WT = Wout; }
        else if ((r -= I_OUT) < I_FF) { W = w_fg; ld = D_FF; K = DM; N = D_FF; WT = Wgu; mode = 1; }
        else if ((r -= I_FF) < I_FF) { W = w_fu; ld = D_FF; K = DM; N = D_FF; WT = Wgu; mode = 2; }
        else { r -= I_FF; W = w_fd; ld = DM; K = D_FF; N = DM; WT = Wdn; }
        const int nb = N / 32, kb = r / nb, n0 = (r % nb) * 32;
        const int drow0 = mode == 0 ? n0 : (n0 >> 7) * 256 + (n0 & 127) + (mode == 2 ? 128 : 0);
        transpose_item(W, ld, ldt ? ldt : K, WT, kb * 64, n0, drow0, scr, lane, mode ? a.in[18] + l * DM : (nm ? a.in[1] + l * DM : nullptr));
    }
}
template <bool FORGET>
__device__ __forceinline__ void phase_rmsnorm(const float* x, const bf16* xb, bf16* xb_out, const float* g, float* rstd_out, const LAS float* wf, const float* bfg, float* logf, int wave, int lane, int vcu, int G) {
    const int gw = vcu * NWAVES + wave, NGW = G * NWAVES;
    f32x4 gv[8];
#pragma unroll
    for (int j = 0; j < 8; ++j) gv[j] = *(const f32x4*)(g + 4 * lane + 256 * j);
    for (int m = gw; m < M; m += NGW) {
        f32x4 v[8]; float s = 0.f;
        if (x) {
            const GAS f32x4* xr = (const GAS f32x4*)(x + (size_t)m * DM) + lane;
#pragma unroll
            for (int j = 0; j < 8; ++j) v[j] = xr[64 * j];
            GAS unsigned long long* x8 = (GAS unsigned long long*)(xb_out + (size_t)m * DM) + lane;
#pragma unroll
            for (int j = 0; j < 8; ++j) { const unsigned lo = pk2(v[j].x, v[j].y), hi = pk2(v[j].z, v[j].w); x8[64 * j] = (unsigned long long)lo | ((unsigned long long)hi << 32);
                v[j] = (f32x4){bflo(lo), bfhi(lo), bflo(hi), bfhi(hi)}; }
        } else {
            const GAS unsigned long long* xr = (const GAS unsigned long long*)(xb + (size_t)m * DM) + lane;
            unsigned long long t[8];
#pragma unroll
            for (int j = 0; j < 8; ++j) t[j] = xr[64 * j];
#pragma unroll
            for (int j = 0; j < 8; ++j) { const unsigned lo = (unsigned)t[j], hi = (unsigned)(t[j] >> 32); v[j] = (f32x4){bflo(lo), bfhi(lo), bflo(hi), bfhi(hi)}; }
        }
#pragma unroll
        for (int j = 0; j < 8; ++j) s += (v[j].x * v[j].x + v[j].y * v[j].y) + (v[j].z * v[j].z + v[j].w * v[j].w);
        const float rstd = 1.0f / sqrtf(wave_sum(s) * (1.f / DM) + EPS);
#pragma unroll
        for (int j = 0; j < 8; ++j) v[j] = v[j] * rstd * gv[j];
        if (lane == 0) rstd_out[m] = rstd;
        if constexpr (FORGET) {
            float d[5];
#pragma unroll
            for (int h = 0; h < 5; ++h) { float p = 0.f;
#pragma unroll
                for (int j = 0; j < 8; ++j) { const f32x4 w = *(const LAS f32x4*)(wf + h * DM + 4 * lane + 256 * j); p += (v[j].x * w.x + v[j].y * w.y) + (v[j].z * w.z + v[j].w * w.w); }
                d[h] = wave_sum(p); asm volatile("" ::: "memory"); }
            if (lane < 5) { float dv = d[0]; dv = lane == 1 ? d[1] : dv; dv = lane == 2 ? d[2] : dv; dv = lane == 3 ? d[3] : dv; dv = lane == 4 ? d[4] : dv;
                const int b = m / SEQ, s_ = m % SEQ; logf[(size_t)(b * H_FOX + lane) * SEQ + s_] = logsigmoidf(dv + bfg[lane]); }
        }
    }
}

namespace att {
typedef short bf16x8 __attribute__((ext_vector_type(8)));
typedef short s16x4 __attribute__((ext_vector_type(4)));
typedef float f32x16 __attribute__((ext_vector_type(16)));
typedef float f32x4 __attribute__((ext_vector_type(4)));
typedef unsigned u32x4 __attribute__((ext_vector_type(4)));
constexpr int SHM = 16384;
constexpr int L_V = 0, L_K = 2 * SHM, L_BIAS = 4 * SHM, L_WS = L_BIAS + 512, L_FLAG = L_WS + 8 * 256, L_QW = L_FLAG + 128, L_QF = L_QW + 64  , L_END = L_QF + 8 * 4096;
constexpr float LOG2E = 1.4426950408889634f, LN2 = 0.6931471805599453f;
enum { MODE_SB = 0, MODE_DIFF = 1, MODE_FOX = 2 };

__device__ __forceinline__ int kswz(int row, int colB) { return row * 256 + (colB ^ ((row & 7) << 4)); }
__device__ __forceinline__ int v_st(int k, int c) { const int kk = (k & ~0xC) | ((k & 4) << 1) | ((k & 8) >> 1); return ((kk >> 3) * 4 + (c >> 5)) * 512 + ((kk & 7) * 32 + (c & 31)) * 2; }
__device__ __forceinline__ int v_rd_base(int lane) { return ((lane & 3) << 3) | (((lane >> 2) & 3) << 6) | (((lane >> 4) & 1) << 5) | (((lane >> 5) & 1) << 8); }
constexpr int v_rd_off(int d0, int ks, int half) { return d0 * 512 + ks * 4096 + half * 2048; }
__device__ __forceinline__ int crow(int r, int hi) { return (r & 3) + 8 * (r >> 2) + 4 * hi; }
__device__ __forceinline__ unsigned cvtpk(float lo, float hi) { unsigned r; asm volatile("v_cvt_pk_bf16_f32 %0, %1, %2" : "=v"(r) : "v"(lo), "v"(hi)); return r; }
__device__ __forceinline__ void unpack8(bf16x8 v, float* a) { const u32x4 w = __builtin_bit_cast(u32x4, v);
    a[0] = __uint_as_float(w.x << 16); a[1] = __uint_as_float(w.x & 0xffff0000u); a[2] = __uint_as_float(w.y << 16); a[3] = __uint_as_float(w.y & 0xffff0000u);
    a[4] = __uint_as_float(w.z << 16); a[5] = __uint_as_float(w.z & 0xffff0000u); a[6] = __uint_as_float(w.w << 16); a[7] = __uint_as_float(w.w & 0xffff0000u); }
__device__ __forceinline__ bf16x8 pack8f(const float* a) { u32x4 w = {cvtpk(a[0], a[1]), cvtpk(a[2], a[3]), cvtpk(a[4], a[5]), cvtpk(a[6], a[7])}; return __builtin_bit_cast(bf16x8, w); }
__device__ __forceinline__ float swap_max(float v) { auto rr = __builtin_amdgcn_permlane32_swap(__float_as_uint(v), __float_as_uint(v), false, false); return fmaxf(__uint_as_float(rr[0]), __uint_as_float(rr[1])); }
__device__ __forceinline__ float swap_add(float v) { auto rr = __builtin_amdgcn_permlane32_swap(__float_as_uint(v), __float_as_uint(v), false, false); return __uint_as_float(rr[0]) + __uint_as_float(rr[1]); }
template <int CTRL> __device__ __forceinline__ float dpp_mov(float v) { return __builtin_bit_cast(float, __builtin_amdgcn_update_dpp(0, __builtin_bit_cast(int, v), CTRL, 0xf, 0xf, true)); }
__device__ __forceinline__ float sum8(float v) { v += dpp_mov<0xB1>(v); v += dpp_mov<0x4E>(v); v += dpp_mov<0x141>(v); return v; }
__device__ __forceinline__ float sum16(float v) { v = sum8(v); v += dpp_mov<0x140>(v); return v; }
__device__ __forceinline__ float sum32(float v) { v = sum16(v); v += __builtin_bit_cast(float, __builtin_amdgcn_ds_swizzle(__builtin_bit_cast(int, v), 0x401F)); return v; }

template <int ND0, bool INIT = false>
__device__ __forceinline__ void qkt(f32x16& p0, f32x16& p1, const LAS unsigned char* Kb, int d0lo, int r32, int hi, const bf16x8* qr) {
    if (!INIT) {
#pragma unroll
        for (int r = 0; r < 16; ++r) { p0[r] = 0.f; p1[r] = 0.f; } }
#pragma unroll
    for (int d = 0; d < ND0; ++d) { const LAS unsigned char* a = Kb + kswz(r32, (d0lo + d) * 32 + hi * 16);
        const bf16x8 b0 = *(const LAS bf16x8*)a, b1 = *(const LAS bf16x8*)(a + 32 * 256);
        p0 = __builtin_amdgcn_mfma_f32_32x32x16_bf16(b0, qr[d], p0, 0, 0, 0);
        p1 = __builtin_amdgcn_mfma_f32_32x32x16_bf16(b1, qr[d], p1, 0, 0, 0); }
}
template <int ND0>
__device__ __forceinline__ void qkt_lq(f32x16& p0, f32x16& p1, const LAS unsigned char* Kb, int d0lo, int r32, int hi, const LAS unsigned char* qf) {
#pragma unroll
    for (int d = 0; d < ND0; ++d) { const LAS unsigned char* a = Kb + kswz(r32, (d0lo + d) * 32 + hi * 16);
        const bf16x8 b0 = *(const LAS bf16x8*)a, b1 = *(const LAS bf16x8*)(a + 32 * 256), q = *(const LAS bf16x8*)(qf + d * 1024);
        p0 = __builtin_amdgcn_mfma_f32_32x32x16_bf16(b0, q, p0, 0, 0, 0);
        p1 = __builtin_amdgcn_mfma_f32_32x32x16_bf16(b1, q, p1, 0, 0, 0); }
}
__device__ __forceinline__ void pv_tile(f32x16* o, int vb, bf16x8 pa0, bf16x8 pa1, bf16x8 pa2, bf16x8 pa3) {
#define TRRD(dst, off) asm volatile("ds_read_b64_tr_b16 %0, %1 offset:%2" : "=&v"(dst) : "v"(vb), "i"(off) : "memory")
#define PV_D0(d0) do { s16x4 l0, l1, l2, l3, h0, h1, h2, h3; constexpr int b_ = v_rd_off(d0, 0, 0); \
        TRRD(l0, b_); TRRD(h0, b_ + 2048); TRRD(l1, b_ + 4096); TRRD(h1, b_ + 6144); TRRD(l2, b_ + 8192); TRRD(h2, b_ + 10240); TRRD(l3, b_ + 12288); TRRD(h3, b_ + 14336); \
        asm volatile("s_waitcnt lgkmcnt(0)" ::: "memory"); __builtin_amdgcn_sched_barrier(0); \
        o[d0] = __builtin_amdgcn_mfma_f32_32x32x16_bf16(pa0, (bf16x8){l0[0], l0[1], l0[2], l0[3], h0[0], h0[1], h0[2], h0[3]}, o[d0], 0, 0, 0); \
        o[d0] = __builtin_amdgcn_mfma_f32_32x32x16_bf16(pa1, (bf16x8){l1[0], l1[1], l1[2], l1[3], h1[0], h1[1], h1[2], h1[3]}, o[d0], 0, 0, 0); \
        o[d0] = __builtin_amdgcn_mfma_f32_32x32x16_bf16(pa2, (bf16x8){l2[0], l2[1], l2[2], l2[3], h2[0], h2[1], h2[2], h2[3]}, o[d0], 0, 0, 0); \
        o[d0] = __builtin_amdgcn_mfma_f32_32x32x16_bf16(pa3, (bf16x8){l3[0], l3[1], l3[2], l3[3], h3[0], h3[1], h3[2], h3[3]}, o[d0], 0, 0, 0); } while (0)
    PV_D0(0); PV_D0(1); PV_D0(2); PV_D0(3);
#undef PV_D0
#undef TRRD
}
__device__ __forceinline__ void pack_p(const f32x16& p0, const f32x16& p1, bf16x8& pa0, bf16x8& pa1, bf16x8& pa2, bf16x8& pa3) {
#define PK4(P, B_, OUT) do { unsigned a0 = cvtpk(P[B_ + 0], P[B_ + 1]), a1 = cvtpk(P[B_ + 2], P[B_ + 3]); \
        unsigned b0 = cvtpk(P[B_ + 4], P[B_ + 5]), b1 = cvtpk(P[B_ + 6], P[B_ + 7]); \
        auto r0 = __builtin_amdgcn_permlane32_swap(a0, b0, false, false); auto r1 = __builtin_amdgcn_permlane32_swap(a1, b1, false, false); \
        u32x4 w = {r0[0], r1[0], r0[1], r1[1]}; OUT = __builtin_bit_cast(bf16x8, w); } while (0)
    PK4(p0, 0, pa0); PK4(p0, 8, pa1); PK4(p1, 0, pa2); PK4(p1, 8, pa3);
#undef PK4
}

struct Stage { bf16x8 k0, k1, v0, v1; float bias; };
template <int MODE> __device__ __forceinline__ void st_load(Stage& S, const bf16* Kg, const bf16* Vg, const float* cu, int j, int sr, int sc, int tid) {
    const size_t r0 = (size_t)(64 * j + sr) * HLD + sc, r1 = r0 + (size_t)32 * HLD;
    S.k0 = *(const GAS bf16x8*)(Kg + r0); S.k1 = *(const GAS bf16x8*)(Kg + r1);
    S.v0 = *(const GAS bf16x8*)(Vg + r0); S.v1 = *(const GAS bf16x8*)(Vg + r1);
    if (MODE == MODE_FOX) { if (tid < 64) S.bias = cu[64 * j + tid]; }
}
__device__ __forceinline__ float min32(float v) { v = fminf(v, dpp_mov<0xB1>(v)); v = fminf(v, dpp_mov<0x4E>(v)); v = fminf(v, dpp_mov<0x141>(v)); v = fminf(v, dpp_mov<0x140>(v));
    return fminf(v, __builtin_bit_cast(float, __builtin_amdgcn_ds_swizzle(__builtin_bit_cast(int, v), 0x401F))); }
template <int MODE> __device__ __forceinline__ bf16x8 knorm(bf16x8 k) {
    if (MODE == MODE_SB) return k;
    float a[8]; unpack8(k, a);
    float ss = (a[0] * a[0] + a[1] * a[1]) + (a[2] * a[2] + a[3] * a[3]) + (a[4] * a[4] + a[5] * a[5]) + (a[6] * a[6] + a[7] * a[7]);
    ss = (MODE == MODE_FOX) ? sum16(ss) : sum8(ss);
    const float rs = __builtin_amdgcn_rsqf(ss * (MODE == MODE_FOX ? (1.f / 128.f) : (1.f / 64.f)) + EPS);
#pragma unroll
    for (int i = 0; i < 8; ++i) a[i] *= rs;
    return pack8f(a);
}
template <int MODE> __device__ __forceinline__ void st_write(const Stage& S, LAS unsigned char* lds, int buf, int kws, int vst0, int vst1, int tid) {
    const bf16x8 k0 = S.k0, k1 = S.k1;
    *(LAS bf16x8*)(lds + L_K + buf * SHM + kws) = k0; *(LAS bf16x8*)(lds + L_K + buf * SHM + kws + 32 * 256) = k1;
    *(LAS bf16x8*)(lds + L_V + buf * SHM + vst0) = S.v0; *(LAS bf16x8*)(lds + L_V + buf * SHM + vst1) = S.v1;
    if (MODE == MODE_FOX) { if (tid < 64) ((LAS float*)(lds + L_BIAS))[buf * 64 + tid] = -S.bias * LOG2E; }
}

__device__ __forceinline__ void st_load_diff(Stage& S, const bf16* Kg, const bf16* Vg, int j, int sr, int sc, int kr, int kc) {
    const size_t r0 = (size_t)(64 * j + sr) * HLD + sc, r1 = r0 + (size_t)32 * HLD;
    S.k0 = *(const GAS bf16x8*)(Kg + (size_t)(64 * j + kr) * HLD + kc);
    S.v0 = *(const GAS bf16x8*)(Vg + r0); S.v1 = *(const GAS bf16x8*)(Vg + r1);
}
__device__ __forceinline__ void st_write_diff(const Stage& S, LAS unsigned char* lds, int buf, int kwd, int vst0, int vst1) {
    *(LAS bf16x8*)(lds + L_K + buf * SHM + kwd) = S.k0;
    *(LAS bf16x8*)(lds + L_V + buf * SHM + vst0) = S.v0; *(LAS bf16x8*)(lds + L_V + buf * SHM + vst1) = S.v1;
}
__device__ __forceinline__ void softmax_step(f32x16& p0, f32x16& p1, float& m_run, float& l_run, f32x16* o, LAS float* al_l, int r32, int hi, bool first, bf16x8& pa0, bf16x8& pa1, bf16x8& pa2, bf16x8& pa3) {
    float pmax = p0[0];
#pragma unroll
    for (int r = 1; r < 16; ++r) pmax = fmaxf(pmax, p0[r]);
#pragma unroll
    for (int r = 0; r < 16; ++r) pmax = fmaxf(pmax, p1[r]);
    pmax = swap_max(pmax);
    const float shift = first ? pmax : fmaxf(pmax, 0.f);
    const float alpha = first ? 1.f : __builtin_amdgcn_exp2f(-shift);
    m_run += shift;
    if (__any(shift != 0.f)) {
        if (hi == 0) al_l[r32] = alpha;
#pragma unroll
        for (int r = 0; r < 16; ++r) { p0[r] -= shift; p1[r] -= shift; }
        asm volatile("s_waitcnt lgkmcnt(0)" ::: "memory");
#pragma unroll
        for (int g = 0; g < 4; ++g) { const f32x4 f = *(const LAS f32x4*)(al_l + 8 * g + 4 * hi);
#pragma unroll
            for (int d = 0; d < 4; ++d)
#pragma unroll
                for (int i = 0; i < 4; ++i) o[d][4 * g + i] *= f[i]; }
    }
    float ps = 0.f;
#pragma unroll
    for (int r = 0; r < 16; ++r) { p0[r] = __builtin_amdgcn_exp2f(p0[r]); ps += p0[r]; }
#pragma unroll
    for (int r = 0; r < 16; ++r) { p1[r] = __builtin_amdgcn_exp2f(p1[r]); ps += p1[r]; }
    ps = swap_add(ps);
    l_run = l_run * alpha + ps;
    pack_p(p0, p1, pa0, pa1, pa2, pa3);
}
__device__ __forceinline__ void row_table(float x, LAS float* tb, int r32, int hi, float* f) {
    if (hi == 0) tb[r32] = x;
    asm volatile("s_waitcnt lgkmcnt(0)" ::: "memory");
#pragma unroll
    for (int g = 0; g < 4; ++g) { const f32x4 v = *(const LAS f32x4*)(tb + 8 * g + 4 * hi); f[4 * g + 0] = v[0]; f[4 * g + 1] = v[1]; f[4 * g + 2] = v[2]; f[4 * g + 3] = v[3]; }
    asm volatile("s_waitcnt lgkmcnt(0)" ::: "memory");
}
__device__ __forceinline__ void store_o(const f32x16* o, bf16* Ow, int r32, int hi) {
#pragma unroll
    for (int r = 0; r < 16; ++r) { const int orow = crow(r, hi);
#pragma unroll
        for (int d0 = 0; d0 < 4; ++d0) { const float v = o[d0][r]; const float vn = dpp_mov<0xB1>(v);
            if ((r32 & 1) == 0) *(GAS unsigned*)(Ow + (size_t)orow * DM + d0 * 32 + r32) = cvtpk(v, vn); } }
}

struct UnitP { const bf16* H; bf16* O; const float* cum; float* stash; const float* gq; const float* gk; const float* subg; float lam, one_m_li; };

__device__ __forceinline__ void unit_fox(const UnitP& P, int b, int h, int qb, LAS unsigned char* lds) {
    int tid = threadIdx.x; asm volatile("" : "+v"(tid));
    const int wid = __builtin_amdgcn_readfirstlane(tid >> 6), lane = tid & 63, r32 = lane & 31, hi = lane >> 5;
    const int q0 = qb * 256, trow = q0 + 32 * wid + r32, tmin = q0 + 32 * wid; const size_t rb = (size_t)b * SEQ;
    const bf16* Kg = P.H + hslot(KC + h * HD) + rb * HLD; const bf16* Vg = P.H + hslot(VC + h * HD) + rb * HLD; const bf16* Qg = P.H + hslot(QC + h * HD) + (rb + trow) * HLD;
    const float* cu = P.cum + (size_t)(b * H_FOX + h) * SEQ;
    const int sr = tid >> 4, sc = (tid & 15) * 8, kws = kswz(sr, sc * 2), vst0 = v_st(sr, sc), vst1 = v_st(32 + sr, sc);
    const int vb0 = (int)(uintptr_t)(lds + L_V) + v_rd_base(lane);
    LAS float* wsf = (LAS float*)(lds + L_WS) + wid * 64;
    bf16x8 qr[8];
    { float ss = 0.f;
#pragma unroll
      for (int d0 = 0; d0 < 8; ++d0) { qr[d0] = *(const GAS bf16x8*)(Qg + d0 * 16 + hi * 8); float a[8]; unpack8(qr[d0], a);
#pragma unroll
          for (int i = 0; i < 8; ++i) ss += a[i] * a[i]; }
      ss = swap_add(ss);
      const float rs = __builtin_amdgcn_rsqf(ss * (1.f / 128.f) + EPS) * (0.08838834764831845f * LOG2E);
#pragma unroll
      for (int d0 = 0; d0 < 8; ++d0) { float a[8]; unpack8(qr[d0], a); const int d = d0 * 16 + hi * 8;
          const f32x4 g0 = *(const f32x4*)(P.gq + d), g1 = *(const f32x4*)(P.gq + d + 4), k0 = *(const f32x4*)(P.gk + d), k1 = *(const f32x4*)(P.gk + d + 4);
#pragma unroll
          for (int i = 0; i < 4; ++i) { a[i] *= rs * g0[i] * k0[i]; a[4 + i] *= rs * g1[i] * k1[i]; }
          qr[d0] = pack8f(a); } }
    float m_run = 0.f, l_run = 0.f; f32x16 o[4];
#pragma unroll
    for (int d = 0; d < 4; ++d)
#pragma unroll
        for (int r = 0; r < 16; ++r) o[d][r] = 0.f;
    const int NT = 4 * qb + 4, jw = (tmin + 31) >> 6;
    Stage SA, SB; st_load<MODE_FOX>(SA, Kg, Vg, cu, NT - 1, sr, sc, tid); st_write<MODE_FOX>(SA, lds, 0, kws, vst0, vst1, tid);
    __syncthreads();
    st_load<MODE_FOX>(SA, Kg, Vg, cu, NT - 2, sr, sc, tid);
    const int i0 = NT - 1 - jw;
#define FOX_COMPUTE(j_, buf_) do { \
            f32x16 p0, p1; \
            const LAS float* bb = (const LAS float*)(lds + L_BIAS) + (buf_) * 64 + 4 * hi; \
            _Pragma("unroll") for (int g = 0; g < 4; ++g) { const f32x4 x = *(const LAS f32x4*)(bb + 8 * g), y = *(const LAS f32x4*)(bb + 32 + 8 * g); \
                _Pragma("unroll") for (int i2 = 0; i2 < 4; ++i2) { p0[4 * g + i2] = x[i2] - m_run; p1[4 * g + i2] = y[i2] - m_run; } } \
            qkt<8, true>(p0, p1, lds + L_K + (buf_) * SHM, 0, r32, hi, qr); \
            if (64 * (j_) + 63 > tmin) { const int dq = trow - 64 * (j_) - 4 * hi; const float NEG = -__builtin_inff(); \
                _Pragma("unroll") for (int r = 0; r < 16; ++r) { const int c = (r & 3) + 8 * (r >> 2); if (c > dq) p0[r] = NEG; if (c + 32 > dq) p1[r] = NEG; } } \
            bf16x8 pa0, pa1, pa2, pa3; \
            softmax_step(p0, p1, m_run, l_run, o, wsf, r32, hi, (j_) == jw, pa0, pa1, pa2, pa3); \
            pv_tile(o, vb0 + (buf_) * SHM, pa0, pa1, pa2, pa3); } while (0)
    for (int i = 0; i < NT; i += 2) {
        { const int j = NT - 1 - i;
          if (i + 2 < NT) st_load<MODE_FOX>(SB, Kg, Vg, cu, j - 2, sr, sc, tid);
          if (i >= i0) FOX_COMPUTE(j, 0);
          st_write<MODE_FOX>(SA, lds, 1, kws, vst0, vst1, tid);
          __syncthreads(); }
        { const int j = NT - 2 - i;
          if (i + 3 < NT) st_load<MODE_FOX>(SA, Kg, Vg, cu, j - 2, sr, sc, tid);
          if (i + 1 >= i0) FOX_COMPUTE(j, 1);
          if (i + 2 < NT) st_write<MODE_FOX>(SB, lds, 0, kws, vst0, vst1, tid);
          __syncthreads(); }
    }
#undef FOX_COMPUTE
    float rl[16]; row_table(__builtin_amdgcn_rcpf(l_run), wsf + 32, r32, hi, rl);
#pragma unroll
    for (int d = 0; d < 4; ++d)
#pragma unroll
        for (int r = 0; r < 16; ++r) o[d][r] *= rl[r];
    store_o(o, P.O + (rb + tmin) * DM + OC + h * HD, r32, hi);
}

__device__ __forceinline__ void unit_diff(const UnitP& P, int b, int h, int qb, float slope2, LAS unsigned char* lds) {
    int tid = threadIdx.x; asm volatile("" : "+v"(tid));
    const int wid = __builtin_amdgcn_readfirstlane(tid >> 6), lane = tid & 63, r32 = lane & 31, hi = lane >> 5;
    const int q0 = qb * 256, trow = q0 + 32 * wid + r32, tmin = q0 + 32 * wid; const size_t rb = (size_t)b * SEQ;
    const bf16* Kg = P.H + hslot(KB_ + h * HD) + rb * HLD; const bf16* Vg = P.H + hslot(VB_ + h * HD) + rb * HLD; const bf16* Qg = P.H + hslot(QB_ + h * HD) + (rb + trow) * HLD;
    const int sr = tid >> 4, sc = (tid & 15) * 8, kws = kswz(sr, sc * 2), vst0 = v_st(sr, sc), vst1 = v_st(32 + sr, sc);
    const int vb0 = (int)(uintptr_t)(lds + L_V) + v_rd_base(lane);
    LAS float* wsf = (LAS float*)(lds + L_WS) + wid * 64;
    const int NT = 4 * qb + 4, jw = tmin >> 6;
    float* stash = P.stash + (size_t)blockIdx.x * 32768;
    LAS unsigned char* qf = lds + L_QF + wid * 4096 + lane * 16;
    f32x16 o[4];
    for (int mp = 0; mp < 2; ++mp) {
        bf16x8 qr[4];
        { float ss = 0.f, qn2 = 0.f;
          int tq = trow; asm volatile("" : "+v"(tq));
          const bf16* Qp = P.H + hslot(QB_ + h * HD) + (rb + tq) * HLD + mp * 64 + hi * 8;
#pragma unroll
          for (int d = 0; d < 4; ++d) { qr[d] = *(const GAS bf16x8*)(Qp + d * 16); float a[8]; unpack8(qr[d], a);
#pragma unroll
              for (int i = 0; i < 8; ++i) ss += a[i] * a[i]; }
          ss = swap_add(ss);
          const float rs = __builtin_amdgcn_rsqf(ss * (1.f / 64.f) + EPS) * (0.125f * LOG2E);
#pragma unroll
          for (int d = 0; d < 4; ++d) { float a[8]; unpack8(qr[d], a); const int dd = d * 16 + hi * 8;
              const f32x4 g0 = *(const f32x4*)(P.gq + dd), g1 = *(const f32x4*)(P.gq + dd + 4), k0 = *(const f32x4*)(P.gk + dd), k1 = *(const f32x4*)(P.gk + dd + 4);
#pragma unroll
              for (int i = 0; i < 4; ++i) { a[i] *= rs * g0[i] * k0[i]; a[4 + i] *= rs * g1[i] * k1[i]; }
#pragma unroll
              for (int i = 0; i < 8; ++i) qn2 += a[i] * a[i];
              *(LAS bf16x8*)(qf + d * 1024) = pack8f(a); }
          qn2 = swap_add(qn2);
          const float need = (152.0f + 16.4f * sqrtf(qn2)) / slope2;
          const float smin = min32((float)trow - need);
          if (lane == 0) ((LAS float*)(lds + L_FLAG))[16 + wid] = smin; }
        float m_run = 0.f, l_run = 0.f;
#pragma unroll
        for (int d = 0; d < 4; ++d)
#pragma unroll
            for (int r = 0; r < 16; ++r) o[d][r] = 0.f;
        const int kr = tid >> 3, kc = mp * 64 + (tid & 7) * 8, kwd = kswz(kr, kc * 2);
        Stage S; st_load_diff(S, Kg, Vg, NT - 1, sr, sc, kr, kc); st_write_diff(S, lds, 0, kwd, vst0, vst1);
        __syncthreads();
        int jlo;
        { const LAS f32x4* f4 = (const LAS f32x4*)((LAS float*)(lds + L_FLAG) + 16); const f32x4 fa = f4[0], fb = f4[1];
          const float sm = fminf(fminf(fminf(fa[0], fa[1]), fminf(fa[2], fa[3])), fminf(fminf(fb[0], fb[1]), fminf(fb[2], fb[3])));
          jlo = __builtin_amdgcn_readfirstlane((int)(fmaxf(sm, 0.f) * (1.0f / 64.0f))); if (jlo > NT - 4) jlo = NT - 4; }
        const int NE = NT - jlo;
        const int i0 = NT - 1 - jw;
        for (int i = 0; i < i0; ++i) {
            const int buf = i & 1, j = NT - 1 - i;
            st_load_diff(S, Kg, Vg, j - 1, sr, sc, kr, kc);
            st_write_diff(S, lds, buf ^ 1, kwd, vst0, vst1);
            __syncthreads();
        }
        for (int i = i0; i < NE; ++i) {
            const int buf = i & 1, j = NT - 1 - i;
            if (i + 1 < NE) st_load_diff(S, Kg, Vg, j - 1, sr, sc, kr, kc);
            {
                f32x16 p0, p1;
                const float dq = (float)(trow - 64 * j - 4 * hi);
                const float nm = -m_run;
#pragma unroll
                for (int r = 0; r < 16; ++r) { const float c = (float)((r & 3) + 8 * (r >> 2)); p0[r] = fmaf(-slope2, fabsf(dq - c), nm); p1[r] = fmaf(-slope2, fabsf(dq - (c + 32.f)), nm); }
                qkt_lq<4>(p0, p1, lds + L_K + buf * SHM, mp * 4, r32, hi, qf);
                bf16x8 pa0, pa1, pa2, pa3;
                softmax_step(p0, p1, m_run, l_run, o, wsf, r32, hi, j == jw, pa0, pa1, pa2, pa3);
                pv_tile(o, vb0 + buf * SHM, pa0, pa1, pa2, pa3);
            }
            if (i + 1 < NE) st_write_diff(S, lds, buf ^ 1, kwd, vst0, vst1);
            __syncthreads();
        }
        float rl[16]; row_table(__builtin_amdgcn_rcpf(l_run), wsf + 32, r32, hi, rl);
        int tso = tid; asm volatile("" : "+v"(tso));
        GAS char* stp = (GAS char*)stash + (size_t)tso * 16;
        if (mp == 0) {
#pragma unroll
            for (int d = 0; d < 4; ++d)
#pragma unroll
                for (int g = 0; g < 4; ++g) { f32x4 v; v[0] = o[d][4 * g] * rl[4 * g]; v[1] = o[d][4 * g + 1] * rl[4 * g + 1]; v[2] = o[d][4 * g + 2] * rl[4 * g + 2]; v[3] = o[d][4 * g + 3] * rl[4 * g + 3];
                    *(GAS f32x4*)stp = v; stp += 8192; asm volatile("" : "+v"(stp)); }
        } else {
#pragma unroll
            for (int d = 0; d < 4; ++d)
#pragma unroll
                for (int g = 0; g < 4; ++g) { const f32x4 v = *(const GAS f32x4*)stp; stp += 8192; asm volatile("" : "+v"(stp));
#pragma unroll
                    for (int i = 0; i < 4; ++i) o[d][4 * g + i] = v[i] - P.lam * (o[d][4 * g + i] * rl[4 * g + i]); }
        }
    }
    const f32x4 sg = (f32x4){P.subg[r32], P.subg[32 + r32], P.subg[64 + r32], P.subg[96 + r32]} * P.one_m_li;
#pragma unroll
    for (int r = 0; r < 16; ++r) { float s = (o[0][r] * o[0][r] + o[1][r] * o[1][r]) + (o[2][r] * o[2][r] + o[3][r] * o[3][r]);
        s = sum32(s);
        const float rs = __builtin_amdgcn_rsqf(s * (1.f / 128.f) + EPS);
        o[0][r] *= rs * sg[0]; o[1][r] *= rs * sg[1]; o[2][r] *= rs * sg[2]; o[3][r] *= rs * sg[3]; }
    store_o(o, P.O + (rb + tmin) * DM + OB + h * HD, r32, hi);
}

__device__ __forceinline__ void unit_sb(const UnitP& P, int b, int h, int qb, LAS unsigned char* lds) {
    int tid = threadIdx.x; asm volatile("" : "+v"(tid));
    const int wid = __builtin_amdgcn_readfirstlane(tid >> 6), lane = tid & 63, r32 = lane & 31, hi = lane >> 5;
    const int q0 = qb * 256, trow = q0 + 32 * wid + r32, tmin = q0 + 32 * wid; const size_t rb = (size_t)b * SEQ;
    const bf16* Kg = P.H + hslot(KA + h * HD) + rb * HLD; const bf16* Vg = P.H + hslot(VA + h * HD) + rb * HLD; const bf16* Qg = P.H + hslot(QA + h * HD) + (rb + trow) * HLD;
    const int sr = tid >> 4, sc = (tid & 15) * 8, kws = kswz(sr, sc * 2), vst0 = v_st(sr, sc), vst1 = v_st(32 + sr, sc);
    const int vb0 = (int)(uintptr_t)(lds + L_V) + v_rd_base(lane);
    LAS unsigned* flags = (LAS unsigned*)(lds + L_FLAG);
    bf16x8 qr[8];
#pragma unroll
    for (int d0 = 0; d0 < 8; ++d0) qr[d0] = *(const GAS bf16x8*)(Qg + d0 * 16 + hi * 8);
    f32x16 o[4];
#pragma unroll
    for (int d = 0; d < 4; ++d)
#pragma unroll
        for (int r = 0; r < 16; ++r) o[d][r] = 0.f;
    const int jtop = 4 * qb + 3, NT = jtop + 1;
    const int jw = (tmin + 30) >> 6;
    float carry = 0.f; bool done = false;
    Stage S; st_load<MODE_SB>(S, Kg, Vg, nullptr, jtop, sr, sc, tid); st_write<MODE_SB>(S, lds, 0, kws, vst0, vst1, tid);
    __syncthreads();
    for (int i = 0; i < NT; ++i) {
        const int buf = i & 1, j = jtop - i;
        if (i + 1 < NT) st_load<MODE_SB>(S, Kg, Vg, nullptr, j - 1, sr, sc, tid);
        if (j <= jw && !done) {
            f32x16 z0, z1; qkt<8>(z0, z1, lds + L_K + buf * SHM, 0, r32, hi, qr);
            const int dq = trow - 64 * j - 4 * hi;
            const bool need_mask = 64 * j + 63 >= tmin;
            f32x16 l0, l1;
            typedef float f32x2_ __attribute__((ext_vector_type(2)));
            constexpr float CS = 0.08838834764831845f * LOG2E;
#pragma unroll
            for (int r = 0; r < 16; r += 2) { const int c = (r & 3) + 8 * (r >> 2);
                const f32x2_ u0 = (f32x2_){z0[r], z0[r + 1]} * CS, u1 = (f32x2_){z1[r], z1[r + 1]} * CS;
                const f32x2_ d0 = (f32x2_){__builtin_amdgcn_exp2f(-fabsf(u0.x)), __builtin_amdgcn_exp2f(-fabsf(u0.y))} + 1.0f, d1 = (f32x2_){__builtin_amdgcn_exp2f(-fabsf(u1.x)), __builtin_amdgcn_exp2f(-fabsf(u1.y))} + 1.0f;
                f32x2_ s0 = (f32x2_){fmaxf(u0.x, 0.f), fmaxf(u0.y, 0.f)} + (f32x2_){__builtin_amdgcn_logf(d0.x), __builtin_amdgcn_logf(d0.y)};
                f32x2_ s1 = (f32x2_){fmaxf(u1.x, 0.f), fmaxf(u1.y, 0.f)} + (f32x2_){__builtin_amdgcn_logf(d1.x), __builtin_amdgcn_logf(d1.y)};
                if (need_mask) { if (!(c < dq)) s0.x = 0.f; if (!(c + 1 < dq)) s0.y = 0.f; if (!(c + 32 < dq)) s1.x = 0.f; if (!(c + 33 < dq)) s1.y = 0.f; }
                z0[r] = u0.x; z0[r + 1] = u0.y; z1[r] = u1.x; z1[r + 1] = u1.y;
                l0[r] = -s0.x; l0[r + 1] = -s0.y; l1[r] = -s1.x; l1[r + 1] = -s1.y; }
            float run = carry;
#pragma unroll
            for (int mm = 7; mm >= 0; --mm) {
                float t;
                if (mm >= 4) { const int m = mm - 4; t = (l1[4 * m] + l1[4 * m + 1]) + (l1[4 * m + 2] + l1[4 * m + 3]); } else { t = (l0[4 * mm] + l0[4 * mm + 1]) + (l0[4 * mm + 2] + l0[4 * mm + 3]); }
                auto rr = __builtin_amdgcn_permlane32_swap(__float_as_uint(t), __float_as_uint(t), false, false);
                const float T0 = __uint_as_float(rr[0]), T1 = __uint_as_float(rr[1]);
                const float e1 = run, e0 = run + T1; float ex = hi ? e1 : e0; run = e0 + T0;
                if (mm >= 4) { const int m = mm - 4;
#pragma unroll
                    for (int i2 = 3; i2 >= 0; --i2) { ex += l1[4 * m + i2]; l1[4 * m + i2] = ex; } }
                else {
#pragma unroll
                    for (int i2 = 3; i2 >= 0; --i2) { ex += l0[4 * mm + i2]; l0[4 * mm + i2] = ex; } }
            }
            carry = run;
#pragma unroll
            for (int r = 0; r < 16; r += 2) { const int c = (r & 3) + 8 * (r >> 2);
                const f32x2_ t0 = (f32x2_){z0[r], z0[r + 1]} + (f32x2_){l0[r], l0[r + 1]}, t1 = (f32x2_){z1[r], z1[r + 1]} + (f32x2_){l1[r], l1[r + 1]};
                float w0 = __builtin_amdgcn_exp2f(t0.x), w0b = __builtin_amdgcn_exp2f(t0.y), w1 = __builtin_amdgcn_exp2f(t1.x), w1b = __builtin_amdgcn_exp2f(t1.y);
                if (need_mask) { if (!(c < dq)) w0 = 0.f; if (!(c + 1 < dq)) w0b = 0.f; if (!(c + 32 < dq)) w1 = 0.f; if (!(c + 33 < dq)) w1b = 0.f; }
                z0[r] = w0; z0[r + 1] = w0b; z1[r] = w1; z1[r + 1] = w1b; }
            bf16x8 pa0, pa1, pa2, pa3; pack_p(z0, z1, pa0, pa1, pa2, pa3);
            pv_tile(o, vb0 + buf * SHM, pa0, pa1, pa2, pa3);
            done = __all(carry < -110.f * LOG2E);
        }
        if (lane == 0) flags[(i & 1) * 8 + wid] = (done || j == 0) ? 1u : 0u;
        if (i + 1 < NT) st_write<MODE_SB>(S, lds, buf ^ 1, kws, vst0, vst1, tid);
        __syncthreads();
        { const LAS u32x4* f4 = (const LAS u32x4*)(flags + (i & 1) * 8); const u32x4 fa = f4[0], fb = f4[1];
          if ((fa.x & fa.y & fa.z & fa.w & fb.x & fb.y & fb.z & fb.w) != 0u) break; }
    }
    store_o(o, P.O + (rb + tmin) * DM + OA + h * HD, r32, hi);
    __syncthreads();
}
}

__device__ __forceinline__ int q_pop(gu32* ctr, LAS unsigned char* lds) {
    if (threadIdx.x == 0) *(volatile LAS unsigned*)(lds + att::L_QW) = __hip_atomic_fetch_add(ctr, 1u, RLX_AGENT);
    __syncthreads();
    const unsigned v = *(volatile LAS unsigned*)(lds + att::L_QW);
    __syncthreads();
    return __builtin_amdgcn_readfirstlane((int)v);
}
__device__ __forceinline__ void attention_phase(const Args& a, int l, LAS unsigned char* lds, gu32* ctl, int rep) {
    const float lambda_init = 0.8f - 0.6f * expf(-0.3f * (float)l);
    float lam;
    { const int lane = threadIdx.x & 63; const float p1 = wave_sum(a.in[6][l * 64 + lane] * a.in[7][l * 64 + lane]), p2 = wave_sum(a.in[8][l * 64 + lane] * a.in[9][l * 64 + lane]); lam = __builtin_bit_cast(float, __builtin_amdgcn_readfirstlane(__builtin_bit_cast(int, expf(p1) - expf(p2) + lambda_init))); }
    att::UnitP P; P.H = (const bf16*)(a.ws + WS_H); P.O = (bf16*)(a.ws + WS_O); P.cum = (const float*)(a.ws + WS_CUM); P.stash = (float*)(a.ws + WS_STASH);
    P.subg = a.in[10] + l * 128; P.lam = lam; P.one_m_li = 1.0f - lambda_init;
    const int xme = (int)(xb_xcc_id() & 7u);
    gu32* qc = ctl + CW_Q + (l * 3) * 8 * 64; (void)rep;
    P.gq = a.in[4] + l * 64; P.gk = a.in[5] + l * 64;
    for (int dx = 0; dx < 8; ++dx) { const int x = (xme + dx) & 7; constexpr int NB = BATCH * H_DIFF / 8;
        for (;;) { const int li = q_pop(qc + (0 * 8 + x) * 64, lds); if (li >= NB * 8) break;
            const int qb = 7 - li / NB, bh = x + 8 * (li % NB), h = bh % H_DIFF;
            att::unit_diff(P, bh / H_DIFF, h, qb, exp2f(-8.0f * (float)(h + 1) / 5.0f) * att::LOG2E, lds); } }
    P.gq = a.in[11] + l * 128; P.gk = a.in[12] + l * 128;
    for (int dx = 0; dx < 8; ++dx) { const int x = (xme + dx) & 7; constexpr int NB = BATCH * H_FOX / 8;
        for (;;) { const int li = q_pop(qc + (1 * 8 + x) * 64, lds); if (li >= NB * 8) break;
            const int qb = 7 - li / NB, bh = x + 8 * (li % NB);
            att::unit_fox(P, bh / H_FOX, bh % H_FOX, qb, lds); } }
    for (int dx = 0; dx < 8; ++dx) { const int x = (xme + dx) & 7; constexpr int NB = BATCH * H_SB / 8;
        for (;;) { const int li = q_pop(qc + (2 * 8 + x) * 64, lds); if (li >= NB * 8) break;
            const int qb = 7 - li / NB, bh = x + 8 * (li % NB);
            att::unit_sb(P, bh / H_SB, bh % H_SB, qb, lds); } }
}

__device__ __forceinline__ void phase_scan(const float* logf, float* cum, LAS unsigned char* lds, int tid, int wave, int lane, int G) {
    LAS float* wtot = (LAS float*)(lds);
    for (int seq = blockIdx.x; seq < BATCH * H_FOX; seq += G) {
        const f32x4 v = *(const f32x4*)(logf + (size_t)seq * SEQ + 4 * tid);
        const float p0 = v.x, p1 = p0 + v.y, p2 = p1 + v.z, p3 = p2 + v.w;
        float inc = p3;
#pragma unroll
        for (int off = 1; off < 64; off <<= 1) { const float o = __shfl_up(inc, off); if (lane >= off) inc += o; }
        if (lane == 63) wtot[wave] = inc;
        LDS_WAIT(); __syncthreads();
        float base = inc - p3;
        for (int w = 0; w < wave; ++w) base += wtot[w];
        *(f32x4*)(cum + (size_t)seq * SEQ + 4 * tid) = (f32x4){base + p0, base + p1, base + p2, base + p3};
        __syncthreads();
    }
}

__global__ void __launch_bounds__(NWAVES * 64, 2) mega_fwd(Args args) {
    extern __shared__ __attribute__((aligned(16))) unsigned char lds_raw[];
    LAS unsigned char* lds = (LAS unsigned char*)lds_raw;
    volatile LAS unsigned* MISC = (volatile LAS unsigned*)(lds + MISC_OFF);
    const int G = gridDim.x; const int bx = blockIdx.x; const int vcu = (G % 8 == 0) ? (bx % 8) * (G / 8) + bx / 8 : bx;
#define TID_OPAQUE() int tid = threadIdx.x; asm volatile("" : "+v"(tid)); const int lane = tid & 63, wave = __builtin_amdgcn_readfirstlane(tid >> 6); (void)lane; (void)wave
    unsigned char* ws = args.ws;
    gu32* ctl = (gu32*)(ws + WS_CTL);
    for (int u = threadIdx.x; u < (LDS_BYTES - LDSCTL_OFF) / 4; u += NWAVES * 64) ((LAS unsigned*)(lds + LDSCTL_OFF))[u] = 0u;
    __syncthreads();
    XcdBarrier bar = xcd_barrier_post((unsigned*)(ctl + CW_BAR) + args.li * XCD_BAR_WORDS, MISC + 8);

    bf16* Wig = (bf16*)(ws + WS_WIG); bf16* Wbr = (bf16*)(ws + WS_WBR); bf16* Wout = (bf16*)(ws + WS_WOUT); bf16* Wgu = (bf16*)(ws + WS_WGU); bf16* Wdn = (bf16*)(ws + WS_WDN);
    float* logf = (float*)(ws + WS_LOGF); float* cum = (float*)(ws + WS_CUM);
    bf16* HB = (bf16*)(ws + WS_H); bf16* GB = (bf16*)(ws + WS_G); bf16* OBF = (bf16*)(ws + WS_O); bf16* YB = (bf16*)(ws + WS_Y); bf16* HFF = (bf16*)(ws + WS_HFF); bf16* XB = (bf16*)(ws + WS_XB); float* SSQ = (float*)(ws + WS_SSQ); float* RSTD = (float*)(ws + WS_RSTD);
    float* out = args.out;

    const int s_lo = args.s_lo, s_hi = args.s_hi;
#define IN(s) (s_lo <= (s) && (s) < s_hi)
#define SEAM(s) do { if (IN(s) && IN((s) + 1)) xcd_barrier(bar); } while (0)
    for (int l = 0; l < DEPTH; ++l) {
        const int sb = l * NPH;
        if (sb + NPH <= s_lo || sb >= s_hi) continue;
        if (IN(sb + 0)) for (int rep = 0; rep < (PROBE_REP == 0 ? 2 : 1); ++rep) {
            TID_OPAQUE();
            phase_convert(args, l, lds, wave, lane, vcu, G);
            __syncthreads();
            { const float* w_in = args.in[2] + (size_t)l * DM * D_IN; LAS float* wf = (LAS float*)(lds + RING_OFF);
              for (int k = tid; k < DM; k += NWAVES * 64) { const float* wr_ = w_in + (size_t)k * D_IN + D_QKV;
#pragma unroll
                  for (int h = 0; h < 5; ++h) wf[h * DM + k] = wr_[h]; }
              LDS_WAIT(); __syncthreads();
              phase_rmsnorm<true>(l == 0 ? args.in[0] : nullptr, XB, XB, args.in[1] + l * DM, RSTD, wf, args.in[3] + l * H_FOX, logf, wave, lane, vcu, G);
              __syncthreads(); }
        }
        SEAM(sb + 0);
        if (IN(sb + 1)) for (int rep = 0; rep < (PROBE_REP == 1 ? 2 : 1); ++rep) {
            { TID_OPAQUE(); phase_scan(logf, cum, lds, tid, wave, lane, G); }
            const pg8::Gemm g = pg8::mk_gemm(XB, Wig, M, D_QKV, DM, DM, DM); pg8::StaticOrder S; S.init(M, D_QKV, G, bx);
            pg8::EpiInProj E{HB, HLD, (size_t)M * HLD, (LAS float*)(lds + LDSCTL_OFF + 1024), RSTD, (LAS float*)(lds + LDSCTL_OFF + 1024 + 8192)};
            pg8::gemm_phase<pg8::EpiInProj, pg8::StaticOrder, true, true>(lds + RING_OFF, g, S, E);
        }
        SEAM(sb + 1);
        if (IN(sb + 2)) { attention_phase(args, l, lds, ctl, 0); __syncthreads(); }
        SEAM(sb + 2);
        if (IN(sb + 3)) for (int rep = 0; rep < (PROBE_REP == 3 ? 2 : 1); ++rep) {
            pg8::Gemm g = pg8::mk_gemm(XB, Wig + (size_t)D_QKV * DM, M, DM, DM, DM, DM);
            g.b_stride = DM * DM; g.A_alt = OBF + OA; g.a_off1 = OB - OA; g.a_off2 = OC - OB; g.B_alt = Wbr; g.b_stride_alt = DM * DM; g.K_alt = D_SB; g.k_dec = D_SB - D_DIFF;
            pg8::SixOrder S; S.S.init(M, DM, G, bx);
            pg8::EpiGateBranch E{GB + (size_t)bx * 65536, YB, DM, RSTD, (LAS float*)(lds + LDSCTL_OFF + 1024 + 8192)};
            pg8::gemm_phase<pg8::EpiGateBranch, pg8::SixOrder, true, true>(lds + RING_OFF, g, S, E);
        }
        SEAM(sb + 3);
        if (IN(sb + 4)) {
            const pg8::Gemm g = pg8::mk_gemm(YB, Wout, M, DM, DM, DM, DM); pg8::StaticOrder S; S.init(M, DM, G, bx);
            pg8::EpiResid E{XB, XB, nullptr, DM, SSQ, (LAS float*)(lds + LDSCTL_OFF + 1024)};
            pg8::gemm_phase<pg8::EpiResid, pg8::StaticOrder, true, true>(lds + RING_OFF, g, S, E);
        }
        SEAM(sb + 4);
        if (IN(sb + 6)) for (int rep = 0; rep < (PROBE_REP == 6 ? 2 : 1); ++rep) {
            const pg8::Gemm g = pg8::mk_gemm(XB, Wgu, M, NGU, DM, DM, DM); pg8::StaticOrder S; S.init(M, NGU, G, bx);
            pg8::EpiSwiglu E{HFF, D_FF, SSQ, (LAS float*)(lds + LDSCTL_OFF + 1024), 1.f / DM, EPS};
            pg8::gemm_phase<pg8::EpiSwiglu, pg8::StaticOrder, true, true>(lds + RING_OFF, g, S, E);
        }
        SEAM(sb + 6);
        if (IN(sb + 7)) {
            const pg8::Gemm g = pg8::mk_gemm(HFF, Wdn, M, DM, D_FF, D_FF, D_FF); pg8::StaticOrder S; S.init(M, DM, G, bx);
            pg8::EpiResid E{XB, XB, l == DEPTH - 1 ? out : nullptr, DM, nullptr, (LAS float*)(lds + LDSCTL_OFF + 1024)};
            pg8::gemm_phase<pg8::EpiResid, pg8::StaticOrder, true, true>(lds + RING_OFF, g, S, E);
        }
        SEAM(sb + 7);
    }
#undef IN
#undef SEAM
}

extern "C" void kernel_launch(void* const* d_in, const int* in_sizes, int n_in, void* d_out, int out_size, void* d_ws, size_t ws_size, hipStream_t stream) {
    static int grid = 0;
    if (grid == 0) {
        if (n_in != 22 || in_sizes[0] != M * DM || out_size != M * DM || ws_size < WS_END) {
            fprintf(stderr, "kernel_launch: unexpected shapes (n_in %d, in0 %d, out %d, ws %zu, need %zu)\n", n_in, n_in > 0 ? in_sizes[0] : -1, out_size, ws_size, (size_t)WS_END); grid = -1; return; }
        int dev = 0, cus = 0, per_cu = 0;
        if (hipGetDevice(&dev) != hipSuccess || hipDeviceGetAttribute(&cus, hipDeviceAttributeMultiprocessorCount, dev) != hipSuccess) { grid = -1; return; }
        if (hipFuncSetAttribute((const void*)mega_fwd, hipFuncAttributeMaxDynamicSharedMemorySize, LDS_BYTES) != hipSuccess) { fprintf(stderr, "kernel_launch: hipFuncSetAttribute failed\n"); grid = -1; return; }
        if (hipOccupancyMaxActiveBlocksPerMultiprocessor(&per_cu, (const void*)mega_fwd, NWAVES * 64, LDS_BYTES) != hipSuccess || per_cu < 1)
            fprintf(stderr, "kernel_launch: occupancy query reports %d workgroups per CU\n", per_cu);
        (void)hipGetLastError();
        grid = cus;
    }
    if (grid < 0) return;
    if (hipMemsetAsync((char*)d_ws + WS_CTL, 0, CTL_ZERO_BYTES, stream) != hipSuccess) return;
    Args a{};
    for (int i = 0; i < 22; ++i) a.in[i] = (const float*)d_in[i];
    a.out = (float*)d_out; a.ws = (unsigned char*)d_ws; a.pad = 0;
#if MK_ONE_LAUNCH
    a.s_lo = 0; a.s_hi = NSTEP; a.li = 0;
    hipLaunchKernelGGL(mega_fwd, dim3(grid), dim3(NWAVES * 64), LDS_BYTES, stream, a);
#else
    for (int s = 0; s < NSTEP; ++s) {
        a.s_lo = s; a.s_hi = s + 1; a.li = s;
        hipLaunchKernelGGL(mega_fwd, dim3(grid), dim3(NWAVES * 64), LDS_BYTES, stream, a);
    }
#endif
}
```

```cpp
#include <hip/hip_runtime.h>
#include <cstdio>
#include <cstdint>

#ifndef PROBE_REP
#define PROBE_REP (-1)
#endif
#ifndef MK_ONE_LAUNCH
#define MK_ONE_LAUNCH 1
#endif

namespace pg8 {
#define PG8_LAS __attribute__((address_space(3)))
typedef unsigned short bf16_t;
typedef short bf16x8 __attribute__((ext_vector_type(8)));
typedef float f32x4 __attribute__((ext_vector_type(4)));
typedef unsigned u32x4 __attribute__((ext_vector_type(4)));
constexpr int BM = 256, BK = 64, HALF = 128, HTB = HALF * BK * 2, STAGE_BYTES = 8 * HTB, NXCD = 8, WGM = 4;

__host__ __device__ __forceinline__ int lds_byte(int r, int c) { const int st = r >> 3, rr = r & 7, ch = c >> 3, g = (r >> 1) & 7; return st * 1024 + rr * 128 + ((ch ^ g) * 16) + (c & 7) * 2; }
__host__ __device__ __forceinline__ void stage_rc(int b, int& R, int& C) { const int st = b / 1024, sb = b % 1024, rr = sb / 128, pch = (sb % 128) / 16; R = st * 8 + rr; C = (pch ^ ((R >> 1) & 7)) * 8; }
__host__ __device__ __forceinline__ int perm32(int rho) { const int n = rho >> 4, i = rho & 15; return 8 * (i >> 2) + 4 * n + (i & 3); }

struct Unit { int pm, pn, br; };
struct Gemm { const bf16_t* A; const bf16_t* Bt; int M, N, K, lda, ldb;
              int a_off1, a_off2, b_stride, k_dec;
              const bf16_t* A_alt; const bf16_t* B_alt; int b_stride_alt, K_alt; };
__device__ __forceinline__ Gemm mk_gemm(const bf16_t* A, const bf16_t* Bt, int M, int N, int K, int lda, int ldb) { Gemm g; g.A = A; g.Bt = Bt; g.M = M; g.N = N; g.K = K; g.lda = lda; g.ldb = ldb; g.a_off1 = 0; g.a_off2 = 0; g.b_stride = 0; g.k_dec = 0; g.A_alt = A; g.B_alt = Bt; g.b_stride_alt = 0; g.K_alt = K; return g; }
template <bool SIX> __device__ __forceinline__ const char* gemm_a(const Gemm& g, int br) { if (SIX) { const int i = br >> 1; return (const char*)((br & 1) ? g.A_alt + (size_t)((i > 0) * g.a_off1 + (i > 1) * g.a_off2) : g.A); } return (const char*)(g.A + (size_t)((br > 0) * g.a_off1 + (br > 1) * g.a_off2)); }
template <bool SIX> __device__ __forceinline__ const char* gemm_b(const Gemm& g, int br) { if (SIX) { const int i = br >> 1; return (const char*)((br & 1) ? g.B_alt + (size_t)i * g.b_stride_alt : g.Bt + (size_t)i * g.b_stride); } return (const char*)(g.Bt + (size_t)br * g.b_stride); }
template <bool SIX> __device__ __forceinline__ int gemm_k(const Gemm& g, int br) { if (SIX) { const int i = br >> 1; return (br & 1) ? g.K_alt - (i > 0) * g.k_dec : g.K; } return g.K - (br > 0) * g.k_dec; }

struct StaticOrder {
    static constexpr bool SIX = false;
    int nM, nN, nwg, G, c;
    __host__ __device__ void init(int M, int N, int G_, int c_) { nM = M / BM; nN = N / BM; nwg = nM * nN; G = G_; c = c_; }
    __host__ __device__ __forceinline__ bool next(int i, Unit& u) const {
        const long L = (long)i * G + c; if (L >= nwg) return false;
        int wgid = (int)L; { const int q = nwg / NXCD, r = nwg % NXCD, xcd = wgid % NXCD, off = wgid / NXCD; wgid = (xcd < r ? xcd * (q + 1) : r * (q + 1) + (xcd - r) * q) + off; }
        const int nig = WGM * nN, gid = wgid / nig, fm = gid * WGM, gsz = (nM - fm) < WGM ? (nM - fm) : WGM;
        u.pm = fm + ((wgid % nig) % gsz); u.pn = (wgid % nig) / gsz; u.br = 0; return true;
    }
    __device__ __forceinline__ void a_ready(const Unit&) const {}
    __device__ __forceinline__ void done(const Unit&) const {}
};

struct SixOrder {
    static constexpr bool SIX = true;
    StaticOrder S;
    __device__ __forceinline__ bool next(int ui, Unit& u) const { const int i = ui / 6, br = ui - 6 * i; const bool ok = S.next(i, u); u.br = br; return ok; }
    __device__ __forceinline__ void a_ready(const Unit&) const {}
    __device__ __forceinline__ void done(const Unit&) const {}
};

__device__ __forceinline__ unsigned cvt_pk_bf16(float lo, float hi) { unsigned r; asm volatile("v_cvt_pk_bf16_f32 %0, %1, %2" : "=v"(r) : "v"(lo), "v"(hi)); return r; }
__device__ __forceinline__ float bflo(unsigned w) { return __uint_as_float(w << 16); }
__device__ __forceinline__ float bfhi(unsigned w) { return __uint_as_float(w & 0xffff0000u); }
__device__ __forceinline__ float sigmoidf_fast(float x) { return __builtin_amdgcn_rcpf(1.0f + __builtin_amdgcn_exp2f(-1.4426950408889634f * x)); }
typedef float f32x2 __attribute__((ext_vector_type(2)));
constexpr float NLOG2E = -1.4426950408889634f;
__device__ __forceinline__ f32x2 sig2_scaled(f32x2 x, float k) {
    const f32x2 t = x * k; const f32x2 e = {__builtin_amdgcn_exp2f(t.x), __builtin_amdgcn_exp2f(t.y)}; const f32x2 d = e + 1.0f;
    return (f32x2){__builtin_amdgcn_rcpf(d.x), __builtin_amdgcn_rcpf(d.y)}; }


__device__ __forceinline__ void rstd_to_lds(const float* rstd, int pm, int wid, int lane, PG8_LAS float* dst, int k) {
    if (wid < 4) __builtin_amdgcn_global_load_lds((const unsigned*)(rstd + (size_t)pm * BM + wid * 64 + lane), (PG8_LAS unsigned*)(dst + k * BM + wid * 64), 4, 0, 0);
}
__device__ __forceinline__ u32x4 lanes_to_rows(u32x4 w, int lane) { const int a = ((lane & 3) * 16 + (lane >> 2)) * 4;
    w.x = (unsigned)__builtin_amdgcn_ds_bpermute(a, (int)w.x); w.y = (unsigned)__builtin_amdgcn_ds_bpermute(a, (int)w.y); w.z = (unsigned)__builtin_amdgcn_ds_bpermute(a, (int)w.z); w.w = (unsigned)__builtin_amdgcn_ds_bpermute(a, (int)w.w); return w; }
__device__ __forceinline__ u32x4 rows_to_lanes(u32x4 w, int lane) { const int a = ((lane & 15) * 4 + (lane >> 4)) * 4;
    w.x = (unsigned)__builtin_amdgcn_ds_bpermute(a, (int)w.x); w.y = (unsigned)__builtin_amdgcn_ds_bpermute(a, (int)w.y); w.z = (unsigned)__builtin_amdgcn_ds_bpermute(a, (int)w.z); w.w = (unsigned)__builtin_amdgcn_ds_bpermute(a, (int)w.w); return w; }
struct EpiInProj {
    static constexpr bool PERM = true, AFTER_DRAIN = false, HAS_STATE = true, HAS_PRE = true;
    struct State { int k; };
    bf16_t* H; int ld; size_t sstride; PG8_LAS float* scr;
    const float* rstd; PG8_LAS float* rl;
    __device__ __forceinline__ void pre(const Unit& u, int wr, int wc, int fr, int fq, State& st) const { st.k ^= 1; rstd_to_lds(rstd, u.pm, wr * 4 + wc, fq * 16 + fr, rl, st.k); }
    __device__ __forceinline__ void operator()(const f32x4 (&acc)[2][2][4][2], const Unit& u, int wr, int wc, int fr, int fq, State& st) const {
        const int row0 = u.pm * BM + wr * 64 + fr; const int colt = u.pn * BM;
        const PG8_LAS float* rp = rl + st.k * BM + wr * 64 + fr;
        const int col0 = colt + wc * 32 + 8 * fq;
        const int h0 = 2 * u.pn, h1 = h0 + 1;
        const int md0 = (h0 >= 23 && h0 <= 27) ? 1 : ((h0 >= 38 && h0 <= 42) ? 2 : 0), md1 = (h1 >= 23 && h1 <= 27) ? 1 : ((h1 >= 38 && h1 <= 42) ? 2 : 0);
        if (md0 | md1) {
#pragma unroll
            for (int ai = 0; ai < 2; ++ai)
#pragma unroll
                for (int m = 0; m < 4; ++m)
#pragma unroll
                    for (int bj = 0; bj < 2; ++bj) { const f32x4 v0 = acc[ai][bj][m][0], v1 = acc[ai][bj][m][1];
                        float ss = ((v0[0] * v0[0] + v0[1] * v0[1]) + (v0[2] * v0[2] + v0[3] * v0[3])) + ((v1[0] * v1[0] + v1[1] * v1[1]) + (v1[2] * v1[2] + v1[3] * v1[3]));
                        ss += __builtin_bit_cast(float, __builtin_amdgcn_ds_swizzle(__builtin_bit_cast(int, ss), 0x401F));
                        { auto rr = __builtin_amdgcn_permlane32_swap(__float_as_uint(ss), __float_as_uint(ss), false, false); ss = __uint_as_float(rr[0]) + __uint_as_float(rr[1]); }
                        if (fq == 0) scr[((wr * 64 + ai * HALF + m * 16 + fr) * 2 + bj) * 4 + wc] = ss; }
            asm volatile("s_waitcnt lgkmcnt(0)" ::: "memory"); __builtin_amdgcn_s_barrier(); asm volatile("" ::: "memory");
        }
        const int lane_ = fq * 16 + fr;
        bf16_t* const HT = H + (size_t)(2 * u.pn) * sstride + (size_t)(u.pm * BM + wr * 64 + (lane_ >> 2)) * ld + wc * 32 + 8 * (lane_ & 3);
#pragma unroll
        for (int ai = 0; ai < 2; ++ai)
#pragma unroll
            for (int m = 0; m < 4; ++m) { bf16_t* rowp = HT + (size_t)(ai * HALF + m * 16) * ld;
                const float rs = rp[ai * HALF + m * 16];
#pragma unroll
                for (int bj = 0; bj < 2; ++bj) { const int md = bj ? md1 : md0; float sc = rs;
                    if (md) { const f32x4 p = *(const PG8_LAS f32x4*)(scr + ((wr * 64 + ai * HALF + m * 16 + fr) * 2 + bj) * 4);
                        const float s64 = ((wc < 2) ? (p[0] + p[1]) : (p[2] + p[3])) * (rs * rs), s128 = ((p[0] + p[1]) + (p[2] + p[3])) * (rs * rs);
                        sc = rs * (md == 1 ? __builtin_amdgcn_rsqf(s64 * (1.f / 64.f) + 1e-6f) : __builtin_amdgcn_rsqf(s128 * (1.f / 128.f) + 1e-6f)); }
                    const f32x4 v0 = acc[ai][bj][m][0] * sc, v1 = acc[ai][bj][m][1] * sc;
                    u32x4 w; w.x = cvt_pk_bf16(v0[0], v0[1]); w.y = cvt_pk_bf16(v0[2], v0[3]); w.z = cvt_pk_bf16(v1[0], v1[1]); w.w = cvt_pk_bf16(v1[2], v1[3]);
                    *(u32x4*)(rowp + bj * sstride) = lanes_to_rows(w, lane_); } }
    }
};
struct EpiGateBranch {
    static constexpr bool PERM = true, AFTER_DRAIN = false, HAS_STATE = true, HAS_PRE = true;
    struct State { unsigned q[16]; int k; };
    bf16_t* GS; bf16_t* Y; int ldy;
    const float* rstd; PG8_LAS float* rl;
    __device__ __forceinline__ void pre(const Unit& u, int wr, int wc, int fr, int fq, State& st) const { if ((u.br & 1) == 0) { st.k ^= 1; rstd_to_lds(rstd, u.pm, wr * 4 + wc, fq * 16 + fr, rl, st.k); } }
    __device__ __forceinline__ void operator()(const f32x4 (&acc)[2][2][4][2], const Unit& u, int wr, int wc, int fr_, int fq, State& st) const {
        int fr = fr_; asm volatile("" : "+v"(fr));
        u32x4* gs = (u32x4*)GS + (((wr * 4 + wc) * 64) + fq * 16 + fr);
        if ((u.br & 1) == 0) {
#pragma unroll
            for (int ai = 0; ai < 2; ++ai) {
                unsigned q[16];
#pragma unroll
                for (int m = 0; m < 4; ++m) { const float rs = rl[st.k * BM + wr * 64 + ai * HALF + m * 16 + fr];
#pragma unroll
                    for (int bj = 0; bj < 2; ++bj) { const f32x4 v0 = acc[ai][bj][m][0], v1 = acc[ai][bj][m][1]; const float k = rs * NLOG2E;
                        unsigned b[8];
                        { const f32x2 s0 = sig2_scaled(v0.lo, k) * 255.f + 0.5f, s1 = sig2_scaled(v0.hi, k) * 255.f + 0.5f, s2 = sig2_scaled(v1.lo, k) * 255.f + 0.5f, s3 = sig2_scaled(v1.hi, k) * 255.f + 0.5f;
                          b[0] = (unsigned)s0.x; b[1] = (unsigned)s0.y; b[2] = (unsigned)s1.x; b[3] = (unsigned)s1.y; b[4] = (unsigned)s2.x; b[5] = (unsigned)s2.y; b[6] = (unsigned)s3.x; b[7] = (unsigned)s3.y; }
                        q[(m * 2 + bj) * 2 + 0] = (b[0] | (b[1] << 8)) | ((b[2] << 16) | (b[3] << 24));
                        q[(m * 2 + bj) * 2 + 1] = (b[4] | (b[5] << 8)) | ((b[6] << 16) | (b[7] << 24)); } }
                if (ai == 0) {
#pragma unroll
                    for (int i = 0; i < 16; ++i) st.q[i] = q[i];
                } else {
#pragma unroll
                    for (int p = 0; p < 4; ++p) gs[p * 512] = (u32x4){q[4 * p], q[4 * p + 1], q[4 * p + 2], q[4 * p + 3]};
                }
            }
        } else {
            const int lane_ = fq * 16 + fr;
            const int row0 = u.pm * BM + wr * 64 + (lane_ >> 2); const int col0 = u.pn * BM + wc * 32 + 8 * (lane_ & 3);
            const bool first = u.br == 1;
            constexpr float Q = 1.f / 255.f;
#pragma unroll
            for (int ai = 0; ai < 2; ++ai) {
                u32x4 y[4][2]; unsigned q[16];
                if (ai == 0) {
#pragma unroll
                    for (int i = 0; i < 16; ++i) q[i] = st.q[i];
                } else {
#pragma unroll
                    for (int p = 0; p < 4; ++p) { const u32x4 t = gs[p * 512]; q[4 * p] = t.x; q[4 * p + 1] = t.y; q[4 * p + 2] = t.z; q[4 * p + 3] = t.w; }
                }
#pragma unroll
                for (int m = 0; m < 4; ++m)
#pragma unroll
                    for (int bj = 0; bj < 2; ++bj) { const size_t r = (size_t)(row0 + ai * HALF + m * 16);
                        if (!first) y[m][bj] = *(const u32x4*)(Y + r * ldy + col0 + bj * HALF); else y[m][bj] = (u32x4){0u, 0u, 0u, 0u}; }
                if (!first) {
#pragma unroll
                    for (int m = 0; m < 4; ++m)
#pragma unroll
                        for (int bj = 0; bj < 2; ++bj) y[m][bj] = rows_to_lanes(y[m][bj], lane_); }
#pragma unroll
                for (int m = 0; m < 4; ++m)
#pragma unroll
                    for (int bj = 0; bj < 2; ++bj) { const size_t r = (size_t)(row0 + ai * HALF + m * 16); const f32x4 v0 = acc[ai][bj][m][0], v1 = acc[ai][bj][m][1]; const u32x4 yy = y[m][bj];
                        const unsigned q0 = q[(m * 2 + bj) * 2 + 0], q1 = q[(m * 2 + bj) * 2 + 1];
                        float o[8];
                        o[0] = ((float)(q0 & 255u) * v0[0]) * Q + bflo(yy.x); o[1] = ((float)((q0 >> 8) & 255u) * v0[1]) * Q + bfhi(yy.x); o[2] = ((float)((q0 >> 16) & 255u) * v0[2]) * Q + bflo(yy.y); o[3] = ((float)(q0 >> 24) * v0[3]) * Q + bfhi(yy.y);
                        o[4] = ((float)(q1 & 255u) * v1[0]) * Q + bflo(yy.z); o[5] = ((float)((q1 >> 8) & 255u) * v1[1]) * Q + bfhi(yy.z); o[6] = ((float)((q1 >> 16) & 255u) * v1[2]) * Q + bflo(yy.w); o[7] = ((float)(q1 >> 24) * v1[3]) * Q + bfhi(yy.w);
                        u32x4 w; w.x = cvt_pk_bf16(o[0], o[1]); w.y = cvt_pk_bf16(o[2], o[3]); w.z = cvt_pk_bf16(o[4], o[5]); w.w = cvt_pk_bf16(o[6], o[7]);
                        *(u32x4*)(Y + r * ldy + col0 + bj * HALF) = lanes_to_rows(w, lane_); }
            }
        }
    }
};
struct EpiResid {
    static constexpr bool PERM = true, AFTER_DRAIN = false, HAS_STATE = false, HAS_PRE = false;
    struct State {};
    const bf16_t* base; bf16_t* outb; float* outf; int ldc; float* ssq; PG8_LAS float* scr;
    __device__ __forceinline__ void operator()(const f32x4 (&acc)[2][2][4][2], const Unit& u, int wr, int wc, int fr, int fq) const {
        const int lane_ = fq * 16 + fr;
        const int row0T = u.pm * BM + wr * 64 + (lane_ >> 2); const int col0T = u.pn * BM + wc * 32 + 8 * (lane_ & 3);
        float ss[2][4];
#pragma unroll
        for (int ai = 0; ai < 2; ++ai) {
            u32x4 b[4][2];
#pragma unroll
            for (int m = 0; m < 4; ++m) { const size_t offT = (size_t)(row0T + ai * HALF + m * 16) * ldc + col0T;
#pragma unroll
                for (int bj = 0; bj < 2; ++bj) b[m][bj] = *(const u32x4*)(base + offT + bj * HALF); }
#pragma unroll
            for (int m = 0; m < 4; ++m)
#pragma unroll
                for (int bj = 0; bj < 2; ++bj) b[m][bj] = rows_to_lanes(b[m][bj], lane_);
#pragma unroll
            for (int m = 0; m < 4; ++m) { const size_t offT = (size_t)(row0T + ai * HALF + m * 16) * ldc + col0T; float sq = 0.f;
#pragma unroll
                for (int bj = 0; bj < 2; ++bj) { const u32x4 bb = b[m][bj]; const f32x4 v0 = acc[ai][bj][m][0], v1 = acc[ai][bj][m][1];
                    const f32x4 o0 = {bflo(bb.x) + v0[0], bfhi(bb.x) + v0[1], bflo(bb.y) + v0[2], bfhi(bb.y) + v0[3]}, o1 = {bflo(bb.z) + v1[0], bfhi(bb.z) + v1[1], bflo(bb.w) + v1[2], bfhi(bb.w) + v1[3]};
                    sq += ((o0[0] * o0[0] + o0[1] * o0[1]) + (o0[2] * o0[2] + o0[3] * o0[3])) + ((o1[0] * o1[0] + o1[1] * o1[1]) + (o1[2] * o1[2] + o1[3] * o1[3]));
                    if (outf) { const u32x4 t0 = lanes_to_rows(__builtin_bit_cast(u32x4, o0), lane_), t1 = lanes_to_rows(__builtin_bit_cast(u32x4, o1), lane_);
                        *(u32x4*)(outf + offT + bj * HALF) = t0; *(u32x4*)(outf + offT + bj * HALF + 4) = t1; }
                    else { u32x4 w; w.x = cvt_pk_bf16(o0[0], o0[1]); w.y = cvt_pk_bf16(o0[2], o0[3]); w.z = cvt_pk_bf16(o1[0], o1[1]); w.w = cvt_pk_bf16(o1[2], o1[3]); *(u32x4*)(outb + offT + bj * HALF) = lanes_to_rows(w, lane_); } }
                ss[ai][m] = sq; }
        }
        if (ssq) {
#pragma unroll
            for (int ai = 0; ai < 2; ++ai)
#pragma unroll
                for (int m = 0; m < 4; ++m) { float t = ss[ai][m];
                    t += __builtin_bit_cast(float, __builtin_amdgcn_ds_swizzle(__builtin_bit_cast(int, t), 0x401F));
                    { auto rr = __builtin_amdgcn_permlane32_swap(__float_as_uint(t), __float_as_uint(t), false, false); t = __uint_as_float(rr[0]) + __uint_as_float(rr[1]); }
                    if (fq == 0) scr[(wr * 64 + ai * HALF + m * 16 + fr) * 4 + wc] = t; }
            asm volatile("s_waitcnt lgkmcnt(0)" ::: "memory"); __builtin_amdgcn_s_barrier(); asm volatile("" ::: "memory");
            const int t_ = (wr * 4 + wc) * 64 + fq * 16 + fr;
            if (t_ < BM) { const f32x4 p = *(const PG8_LAS f32x4*)(scr + t_ * 4); ssq[(size_t)(u.pm * BM + t_) * 8 + u.pn] = (p[0] + p[1]) + (p[2] + p[3]); }
        }
    }
};
struct EpiSwiglu {
    static constexpr bool PERM = true, AFTER_DRAIN = false, HAS_STATE = true, HAS_PRE = true;
    struct State { f32x4 p0, p1; };
    bf16_t* O; int ldo; const float* ssq; PG8_LAS float* scr; float inv_n, eps;
    __device__ __forceinline__ void pre(const Unit& u, int wr, int wc, int fr, int fq, State& st) const {
        const int t_ = ((wr * 4 + wc) * 64 + fq * 16 + fr) & (BM - 1);
        const f32x4* p = (const f32x4*)(ssq + (size_t)(u.pm * BM + t_) * 8); st.p0 = p[0]; st.p1 = p[1];
    }
    __device__ __forceinline__ void operator()(const f32x4 (&acc)[2][2][4][2], const Unit& u, int wr, int wc, int fr, int fq, State& st) const {
        { const int t_ = (wr * 4 + wc) * 64 + fq * 16 + fr;
          const float sum = ((st.p0[0] + st.p0[1]) + (st.p0[2] + st.p0[3])) + ((st.p1[0] + st.p1[1]) + (st.p1[2] + st.p1[3]));
          if (t_ < BM) scr[t_] = __builtin_amdgcn_rsqf(sum * inv_n + eps);
          asm volatile("s_waitcnt lgkmcnt(0)" ::: "memory"); __builtin_amdgcn_s_barrier(); asm volatile("" ::: "memory"); }
        const int lane_ = fq * 16 + fr;
        const int row0 = u.pm * BM + wr * 64 + (lane_ >> 2); const int col0 = u.pn * HALF + wc * 32 + 8 * (lane_ & 3);
#pragma unroll
        for (int ai = 0; ai < 2; ++ai)
#pragma unroll
            for (int m = 0; m < 4; ++m) { bf16_t* rowp = O + (size_t)(row0 + ai * HALF + m * 16) * ldo + col0;
                const float rs = scr[wr * 64 + ai * HALF + m * 16 + fr];
                const float k = rs * NLOG2E, rs2 = rs * rs;
                const f32x4 g0 = acc[ai][0][m][0], g1 = acc[ai][0][m][1], u0 = acc[ai][1][m][0], u1 = acc[ai][1][m][1];
                const f32x2 o0 = (g0.lo * u0.lo) * (sig2_scaled(g0.lo, k) * rs2), o1 = (g0.hi * u0.hi) * (sig2_scaled(g0.hi, k) * rs2), o2 = (g1.lo * u1.lo) * (sig2_scaled(g1.lo, k) * rs2), o3 = (g1.hi * u1.hi) * (sig2_scaled(g1.hi, k) * rs2);
                u32x4 w; w.x = cvt_pk_bf16(o0.x, o0.y); w.y = cvt_pk_bf16(o1.x, o1.y); w.z = cvt_pk_bf16(o2.x, o2.y); w.w = cvt_pk_bf16(o3.x, o3.y);
                *(u32x4*)rowp = lanes_to_rows(w, lane_); }
    }
};

template <class Epi, class Sched, bool ALIGN_EPI = false, bool SP2 = false>
__device__ __forceinline__ void gemm_phase(PG8_LAS unsigned char* lds, const Gemm g, const Sched& S, const Epi& E) {
    int tid_ = threadIdx.x; asm volatile("" : "+v"(tid_));
    const int tid = tid_, wid = __builtin_amdgcn_readfirstlane(tid >> 6), lane = tid & 63, wr = wid >> 2, wc = wid & 3, fr = lane & 15, fq = lane >> 4;
    unsigned voffA[2], voffB[2];
#pragma unroll
    for (int i = 0; i < 2; ++i) { int R, C; stage_rc(tid * 16 + i * 8192, R, C); const int Rb = Epi::PERM ? ((R & ~31) + perm32(R & 31)) : R;
        voffA[i] = (unsigned)(R * g.lda + C) * 2u; voffB[i] = (unsigned)(Rb * g.ldb + C) * 2u; }
    const size_t kstep = (size_t)(BK * 2);
    const size_t hstepA = (size_t)HALF * g.lda * 2, hstepB = (size_t)HALF * g.ldb * 2;
    const size_t tstepA = 2 * hstepA, tstepB = 2 * hstepB;
    const unsigned ldsw = (unsigned)wid * 1024u;
    const int aoff = lds_byte(wr * 64 + fr, fq * 8), boff = lds_byte(wc * 32 + fr, fq * 8);
#define PG8_SA(b, h) (((b) * 2 + (h)) * HTB)
#define PG8_SB(b, h) ((4 + (b) * 2 + (h)) * HTB)
#define PG8_STAGE(bufoff, gbase, voff) do { _Pragma("unroll") for (int _i = 0; _i < 2; ++_i) \
        __builtin_amdgcn_global_load_lds((const unsigned*)((const char*)(gbase) + (voff)[_i]), (PG8_LAS unsigned*)(lds + (bufoff) + ldsw + _i * 8192), 16, 0, 0); } while (0)
#define PG8_LDA(dst, b, h) do { _Pragma("unroll") for (int m = 0; m < 4; ++m) _Pragma("unroll") for (int k = 0; k < 2; ++k) dst[m][k] = *(const PG8_LAS bf16x8*)(lds + PG8_SA(b, h) + (aoff ^ (k * 64)) + m * 2048); } while (0)
#define PG8_LDB(dst, b, h) do { _Pragma("unroll") for (int n = 0; n < 2; ++n) _Pragma("unroll") for (int k = 0; k < 2; ++k) dst[n][k] = *(const PG8_LAS bf16x8*)(lds + PG8_SB(b, h) + (boff ^ (k * 64)) + n * 2048); } while (0)
#define PG8_MMA(ai, bj, At, Bt) do { __builtin_amdgcn_s_setprio(1); _Pragma("unroll") for (int m = 0; m < 4; ++m) _Pragma("unroll") for (int n = 0; n < 2; ++n) _Pragma("unroll") for (int k = 0; k < 2; ++k) \
        acc[ai][bj][m][n] = __builtin_amdgcn_mfma_f32_16x16x32_bf16(Bt[n][k], At[m][k], acc[ai][bj][m][n], 0, 0, 0); __builtin_amdgcn_s_setprio(0); } while (0)
#define PG8_WAIT_V(n) asm volatile("s_waitcnt vmcnt(" #n ")" ::: "memory")
#define PG8_WAIT_L(n) asm volatile("s_waitcnt lgkmcnt(" #n ")" ::: "memory")
#define PG8_BAR __builtin_amdgcn_s_barrier()
#define PG8_SCHED __builtin_amdgcn_sched_barrier(0)
    Unit cur, nxt; int ui = 0;
    if (!S.next(0, cur)) return;
    f32x4 acc[2][2][4][2];
#pragma unroll
    for (int a = 0; a < 2; ++a)
#pragma unroll
        for (int b = 0; b < 2; ++b)
#pragma unroll
            for (int m = 0; m < 4; ++m)
#pragma unroll
                for (int n = 0; n < 2; ++n) acc[a][b][m][n] = (f32x4){0.f, 0.f, 0.f, 0.f};
    bf16x8 At[4][2], B0[2][2], B1[2][2];
    typename Epi::State est{};
    const char* cA = gemm_a<Sched::SIX>(g, cur.br) + (size_t)cur.pm * tstepA; const char* cB = gemm_b<Sched::SIX>(g, cur.br) + (size_t)cur.pn * tstepB;
    S.a_ready(cur);
    if constexpr (SP2) {
        PG8_STAGE(PG8_SB(0, 0), cB, voffB); PG8_STAGE(PG8_SB(0, 1), cB + hstepB, voffB); PG8_STAGE(PG8_SA(0, 0), cA, voffA); PG8_STAGE(PG8_SA(0, 1), cA + hstepA, voffA);
        if (wr == 1) PG8_BAR;
        PG8_WAIT_V(2); PG8_BAR;
        PG8_STAGE(PG8_SB(1, 0), cB + kstep, voffB); PG8_STAGE(PG8_SA(1, 0), cA + kstep, voffA); PG8_STAGE(PG8_SB(1, 1), cB + hstepB + kstep, voffB);
        PG8_WAIT_V(6); PG8_BAR;
    } else {
        PG8_STAGE(PG8_SB(0, 0), cB, voffB); PG8_STAGE(PG8_SA(0, 0), cA, voffA); PG8_STAGE(PG8_SB(0, 1), cB + hstepB, voffB); PG8_STAGE(PG8_SA(0, 1), cA + hstepA, voffA);
        if (wr == 1) PG8_BAR;
        PG8_WAIT_V(4); PG8_BAR;
        PG8_STAGE(PG8_SB(1, 0), cB + kstep, voffB); PG8_STAGE(PG8_SA(1, 0), cA + kstep, voffA); PG8_STAGE(PG8_SB(1, 1), cB + hstepB + kstep, voffB);
        PG8_WAIT_V(6); PG8_BAR;
    }
    for (;;) {
        const bool has_next = S.next(ui + 1, nxt);
        const char* nA = has_next ? gemm_a<Sched::SIX>(g, nxt.br) + (size_t)nxt.pm * tstepA : cA; const char* nB = has_next ? gemm_b<Sched::SIX>(g, nxt.br) + (size_t)nxt.pn * tstepB : cB;
        const int nt = gemm_k<Sched::SIX>(g, cur.br) / BK;
        if constexpr (Epi::HAS_PRE) { int t2 = threadIdx.x; asm volatile("" : "+v"(t2)); E.pre(cur, wr, wc, t2 & 15, (t2 >> 4) & 3, est); }
        for (int t = 0; t < nt; t += 2) {
            const bool last = (t == nt - 2);
            const char* a1 = cA + (size_t)(t + 1) * kstep;
            const char* a2 = last ? nA : cA + (size_t)(t + 2) * kstep; const char* b2 = last ? nB : cB + (size_t)(t + 2) * kstep;
            const char* a3 = a2 + kstep; const char* b3 = b2 + kstep;
            if (last && has_next) S.a_ready(nxt);
            if constexpr (SP2) {
            PG8_LDB(B0, 0, 0); PG8_LDB(B1, 0, 1); PG8_SCHED; PG8_LDA(At, 0, 0); PG8_STAGE(PG8_SA(1, 1), a1 + hstepA, voffA);
            PG8_WAIT_V(8); PG8_WAIT_L(0); PG8_BAR; PG8_MMA(0, 0, At, B0); PG8_MMA(0, 1, At, B1); PG8_BAR; PG8_SCHED;
            PG8_LDA(At, 0, 1); PG8_STAGE(PG8_SB(0, 0), b2, voffB); PG8_STAGE(PG8_SB(0, 1), b2 + hstepB, voffB); PG8_STAGE(PG8_SA(0, 0), a2, voffA);
            PG8_WAIT_V(8); PG8_WAIT_L(0); PG8_BAR; PG8_MMA(1, 0, At, B0); PG8_MMA(1, 1, At, B1); PG8_BAR; PG8_SCHED;
            PG8_LDB(B0, 1, 0); PG8_LDB(B1, 1, 1); PG8_SCHED; PG8_LDA(At, 1, 0); PG8_STAGE(PG8_SA(0, 1), a2 + hstepA, voffA);
            PG8_WAIT_V(8); PG8_WAIT_L(0); PG8_BAR; PG8_MMA(0, 0, At, B0); PG8_MMA(0, 1, At, B1); PG8_BAR; PG8_SCHED;
            PG8_LDA(At, 1, 1); PG8_STAGE(PG8_SB(1, 0), b3, voffB); PG8_STAGE(PG8_SB(1, 1), b3 + hstepB, voffB); PG8_STAGE(PG8_SA(1, 0), a3, voffA);
            PG8_WAIT_V(8); PG8_WAIT_L(0); PG8_BAR; PG8_MMA(1, 0, At, B0); PG8_MMA(1, 1, At, B1); PG8_BAR; PG8_SCHED;
            } else {
            PG8_LDB(B0, 0, 0); PG8_SCHED; PG8_LDA(At, 0, 0); PG8_STAGE(PG8_SA(1, 1), a1 + hstepA, voffA);
            PG8_WAIT_L(8); PG8_BAR; PG8_WAIT_L(0); PG8_MMA(0, 0, At, B0); PG8_BAR; PG8_SCHED;
            PG8_LDB(B1, 0, 1); PG8_STAGE(PG8_SB(0, 0), b2, voffB);
            PG8_BAR; PG8_WAIT_L(0); PG8_MMA(0, 1, At, B1); PG8_BAR;
            PG8_LDA(At, 0, 1); PG8_STAGE(PG8_SA(0, 0), a2, voffA);
            PG8_BAR; PG8_WAIT_L(0); PG8_MMA(1, 0, At, B0); PG8_BAR; PG8_SCHED;
            PG8_STAGE(PG8_SB(0, 1), b2 + hstepB, voffB);
            PG8_WAIT_V(6); PG8_BAR; PG8_MMA(1, 1, At, B1); PG8_BAR;
            PG8_LDB(B0, 1, 0); PG8_SCHED; PG8_LDA(At, 1, 0); PG8_STAGE(PG8_SA(0, 1), a2 + hstepA, voffA);
            PG8_WAIT_L(8); PG8_BAR; PG8_WAIT_L(0); PG8_MMA(0, 0, At, B0); PG8_BAR; PG8_SCHED;
            PG8_LDB(B1, 1, 1); PG8_STAGE(PG8_SB(1, 0), b3, voffB);
            PG8_BAR; PG8_WAIT_L(0); PG8_MMA(0, 1, At, B1); PG8_BAR;
            PG8_LDA(At, 1, 1); PG8_STAGE(PG8_SA(1, 0), a3, voffA);
            PG8_BAR; PG8_WAIT_L(0); PG8_MMA(1, 0, At, B0); PG8_BAR; PG8_SCHED;
            PG8_STAGE(PG8_SB(1, 1), b3 + hstepB, voffB);
            PG8_WAIT_V(6); PG8_BAR; PG8_MMA(1, 1, At, B1); PG8_BAR;
            }
        }
        if constexpr (ALIGN_EPI) { if (wr == 0) PG8_BAR; }
        { int t2 = threadIdx.x; asm volatile("" : "+v"(t2)); const int fr2 = t2 & 15, fq2 = (t2 >> 4) & 3;
          if constexpr (Epi::HAS_STATE) { E(acc, cur, wr, wc, fr2, fq2, est); S.done(cur); } else if constexpr (!Epi::AFTER_DRAIN) { E(acc, cur, wr, wc, fr2, fq2); S.done(cur); } }
        if (!has_next) break;
#pragma unroll
        for (int a = 0; a < 2; ++a)
#pragma unroll
            for (int b = 0; b < 2; ++b)
#pragma unroll
                for (int m = 0; m < 4; ++m)
#pragma unroll
                    for (int n = 0; n < 2; ++n) acc[a][b][m][n] = (f32x4){0.f, 0.f, 0.f, 0.f};
        cur = nxt; cA = nA; cB = nB; ++ui;
        if constexpr (ALIGN_EPI) { if (wr == 1) PG8_BAR; }
    }
    PG8_WAIT_V(0);
    if constexpr (!ALIGN_EPI) { if (wr == 0) PG8_BAR; }
    PG8_BAR;
#undef PG8_SA
#undef PG8_SB
#undef PG8_STAGE
#undef PG8_LDA
#undef PG8_LDB
#undef PG8_MMA
#undef PG8_WAIT_V
#undef PG8_WAIT_L
#undef PG8_BAR
#undef PG8_SCHED
}
}

constexpr int NWAVES = 8;
constexpr int BATCH = 16, SEQ = 2048, DM = 2048, DEPTH = 4;
constexpr int M = BATCH * SEQ;
constexpr int HD = 128, H_SB = 6, H_DIFF = 5, H_FOX = 5;
constexpr int D_SB = 768, D_DIFF = 640, D_FOX = 640;
constexpr int D_QKV = 6144, D_IN = 6149, D_FF = 5632;
constexpr int NGU = 2 * D_FF;
constexpr int QA = 0, KA = 768, VA = 1536, QB_ = 2304, KB_ = 2944, VB_ = 3584, QC = 4224, KC = 4864, VC = 5504;
constexpr int OA = 0, OB = 768, OC = 1408;
constexpr int HLD = 128;
__host__ __device__ constexpr size_t hslot(int col) { return (size_t)(col / 128) * ((size_t)BATCH * SEQ * 128); }
constexpr float EPS = 1e-6f;
constexpr int NPH = 8;
constexpr int NSTEP = DEPTH * NPH;

constexpr size_t MiB = 1u << 20;
constexpr size_t WS_CTL = 0, CTL_ZERO_BYTES = 2 * MiB;
constexpr size_t WS_WIG = 2 * MiB;
constexpr size_t WS_WBR = WS_WIG + 48 * MiB;
constexpr size_t WS_WOUT = WS_WBR + 24 * MiB;
constexpr size_t WS_WGU = WS_WOUT + 8 * MiB;
constexpr size_t WS_WDN = WS_WGU + 44 * MiB;
constexpr size_t WS_LOGF = WS_WDN + 22 * MiB;
constexpr size_t WS_CUM = WS_LOGF + 1 * MiB;
constexpr size_t WS_XN = WS_CUM + 1 * MiB;
constexpr size_t WS_H = WS_XN + 128 * MiB;
constexpr size_t WS_G = WS_H + 384 * MiB;
constexpr size_t WS_O = WS_G + 384 * MiB;
constexpr size_t WS_STASH = WS_O + 128 * MiB;
constexpr size_t WS_END = WS_STASH + 32 * MiB;
constexpr size_t WS_XB = WS_G + 128 * MiB;
constexpr size_t WS_SSQ = WS_G + 256 * MiB;
constexpr size_t WS_RSTD = WS_SSQ + 1 * MiB;
constexpr size_t WS_Y = WS_H;
constexpr size_t WS_HFF = WS_H + 128 * MiB;
static_assert(WS_HFF + (size_t)M * D_FF * 2 <= WS_XB && WS_XB + (size_t)M * DM * 2 <= WS_SSQ && WS_SSQ + (size_t)M * 8 * 4 <= WS_RSTD && WS_RSTD + (size_t)M * 4 <= WS_O, "HFF overlay / residual stream / row statistics");
constexpr int CW_TMO = 0, CW_CODE = 1;
constexpr int CW_Q = 8192;
constexpr int CW_BAR = 4096;

constexpr int RING_OFF = 0, RING_BYTES = 131072;
constexpr int LDSCTL_OFF = RING_BYTES, MISC_OFF = LDSCTL_OFF + 320;
constexpr int LDS_BYTES = 147456;

#define GAS __attribute__((address_space(1)))
#define LAS __attribute__((address_space(3)))
typedef unsigned short bf16;
typedef unsigned v4u __attribute__((ext_vector_type(4)));
typedef unsigned v2u __attribute__((ext_vector_type(2)));
typedef float f32x4 __attribute__((ext_vector_type(4)));
typedef GAS unsigned gu32;
#define RLX_AGENT __ATOMIC_RELAXED, __HIP_MEMORY_SCOPE_AGENT
#define LDS_WAIT() asm volatile("s_waitcnt lgkmcnt(0)" ::: "memory")
#define VM_WAIT() asm volatile("s_waitcnt vmcnt(0)" ::: "memory")
__device__ __forceinline__ unsigned f2bf(float f) { unsigned u = __builtin_bit_cast(unsigned, f); return (u + 0x7fffu + ((u >> 16) & 1u)) >> 16; }
__device__ __forceinline__ unsigned pk2(float lo, float hi) { return f2bf(lo) | (f2bf(hi) << 16); }
__device__ __forceinline__ float bflo(unsigned w) { return __uint_as_float(w << 16); }
__device__ __forceinline__ float bfhi(unsigned w) { return __uint_as_float(w & 0xffff0000u); }

#define XB_TMO      128
#define XB_XCNT(j)  (256  + 64 * (j))
#define XB_XSUB(j)  (1280 + 64 * (j))
#define XB_XGEN(j)  (2304 + 64 * (j))
#define XB_TOP      3328
#define XB_TOPGEN   3392
#define XCD_BAR_WORDS 3456
#define XB_SPIN_CAP (1u << 18)
__device__ __forceinline__ unsigned xb_ld(unsigned* p)              { return __hip_atomic_load(p, __ATOMIC_RELAXED, __HIP_MEMORY_SCOPE_AGENT); }
__device__ __forceinline__ unsigned xb_add(unsigned* p, unsigned v) { return __hip_atomic_fetch_add(p, v, __ATOMIC_RELAXED, __HIP_MEMORY_SCOPE_AGENT); }
__device__ __forceinline__ unsigned xb_xcc_id() { return (unsigned)__builtin_amdgcn_s_getreg((3 << 11) | 20) & 0xFu; }
#define XB_SPIN(cond, bar) do { unsigned _sp = 0; while (cond) { __builtin_amdgcn_s_sleep(1); \
    if ((++_sp & 255u) == 0u) { if (xb_ld(&(bar)[XB_TMO])) break; if (_sp > XB_SPIN_CAP) { atomicAdd(&(bar)[XB_TMO], 1u); break; } } } } while (0)
struct XcdBarrier { unsigned* bar; unsigned x; volatile LAS unsigned* st; };
__device__ __forceinline__ XcdBarrier xcd_barrier_post(unsigned* bar, volatile LAS unsigned* st) {
    XcdBarrier b; b.bar = bar; b.x = xb_xcc_id(); b.st = st;
    if (threadIdx.x == 0) (void)xb_add(&bar[XB_XCNT(b.x)], 1u);
    return b;
}
__device__ __forceinline__ void xcd_barrier_complete(unsigned* bar, unsigned x, unsigned& nloc, unsigned& nx) {
    const unsigned G = gridDim.x * gridDim.y * gridDim.z;
    unsigned sum, cnt, mine, sp = 0u;
    for (;;) {
        sum = 0u; cnt = 0u; mine = 0u;
#pragma unroll
        for (unsigned j = 0; j < 16; ++j) { const unsigned c = xb_ld(&bar[XB_XCNT(j)]); sum += c; cnt += (c > 0u) ? 1u : 0u; mine = (j == x) ? c : mine; }
        if (sum == G) break;
        __builtin_amdgcn_s_sleep(1);
        if ((++sp & 255u) == 0u) { if (xb_ld(&bar[XB_TMO])) break; if (sp > XB_SPIN_CAP) { atomicAdd(&bar[XB_TMO], 1u); break; } }
    }
    nloc = mine > 0u ? mine : 1u; nx = cnt > 0u ? cnt : 1u;
}
__device__ __forceinline__ void xcd_barrier(const XcdBarrier& b) {
    asm volatile("s_waitcnt vmcnt(0)" ::: "memory");
    __syncthreads();
    if (threadIdx.x == 0) {
        unsigned* bar = b.bar;
        __builtin_amdgcn_s_waitcnt(0);
        unsigned nloc = b.st[0], nx = b.st[1];
        if (nloc == 0u) { xcd_barrier_complete(bar, b.x, nloc, nx); b.st[0] = nloc; b.st[1] = nx; }
        const unsigned old = xb_add(&bar[XB_XSUB(b.x)], 1u);
        const unsigned gen = old / nloc;
        if (old + 1u == (gen + 1u) * nloc) {
            __builtin_amdgcn_fence(__ATOMIC_RELEASE, "agent");
            asm volatile("s_waitcnt vmcnt(0)" ::: "memory");
            const unsigned og = xb_add(&bar[XB_TOP], 1u);
            const unsigned tg = og / nx;
            if (og + 1u == (tg + 1u) * nx) xb_add(&bar[XB_TOPGEN], 1u);
            else XB_SPIN(xb_ld(&bar[XB_TOPGEN]) == tg, bar);
            __builtin_amdgcn_fence(__ATOMIC_ACQUIRE, "agent");
            xb_add(&bar[XB_XGEN(b.x)], 1u);
            asm volatile("s_waitcnt vmcnt(0)" ::: "memory");
        } else {
            XB_SPIN(xb_ld(&bar[XB_XGEN(b.x)]) == gen, bar);
            __builtin_amdgcn_fence(__ATOMIC_ACQUIRE, "agent");
            asm volatile("s_waitcnt vmcnt(0)" ::: "memory");
        }
    }
    __syncthreads();
}

__device__ __forceinline__ float wave_sum(float v) {
#pragma unroll
    for (int o = 1; o < 64; o <<= 1) v += __shfl_xor(v, o);
    return v;
}
__device__ __forceinline__ float wave_max(float v) {
#pragma unroll
    for (int o = 1; o < 64; o <<= 1) v = fmaxf(v, __shfl_xor(v, o));
    return v;
}
__device__ __forceinline__ float softplusf(float z) { return fmaxf(z, 0.f) + log1pf(__expf(-fabsf(z))); }
__device__ __forceinline__ float logsigmoidf(float z) { return fminf(z, 0.f) - __logf(1.f + __expf(-fabsf(z))); }

__device__ __forceinline__ void transpose_item(const float* W, int ld, int K, bf16* WT, int k0, int n0, int drow0, LAS float* scr, int lane, const float* ks) {
#pragma unroll 8
    for (int i = 0; i < 32; ++i) { const int kk = 2 * i + (lane >> 5); scr[kk * 33 + (lane & 31)] = W[(size_t)(k0 + kk) * ld + n0 + (lane & 31)]; }
    LDS_WAIT(); asm volatile("" ::: "memory");
    const int c = lane & 7;
    f32x4 k0v = {1.f, 1.f, 1.f, 1.f}, k1v = k0v;
    if (ks) { k0v = *(const f32x4*)(ks + k0 + 8 * c); k1v = *(const f32x4*)(ks + k0 + 8 * c + 4); }
#pragma unroll
    for (int j = 0; j < 4; ++j) { const int n = (lane >> 3) + 8 * j; const LAS float* s = scr + (8 * c) * 33 + n;
        v4u o; o.x = pk2(s[0 * 33] * k0v.x, s[1 * 33] * k0v.y); o.y = pk2(s[2 * 33] * k0v.z, s[3 * 33] * k0v.w); o.z = pk2(s[4 * 33] * k1v.x, s[5 * 33] * k1v.y); o.w = pk2(s[6 * 33] * k1v.z, s[7 * 33] * k1v.w);
        *(GAS v4u*)(WT + (size_t)(drow0 + n) * K + k0 + 8 * c) = o; }
    LDS_WAIT(); asm volatile("" ::: "memory");
}

struct Args { const float* in[22]; float* out; unsigned char* ws; int s_lo, s_hi, li, pad; };

__device__ __forceinline__ void phase_convert(const Args& a, int l, LAS unsigned char* lds, int wave, int lane, int vcu, int G) {
    LAS float* scr = (LAS float*)(lds + RING_OFF + wave * 16384);
    const int gw = vcu * NWAVES + wave, NGW = G * NWAVES;
    unsigned char* ws = a.ws;
    bf16* Wig = (bf16*)(ws + WS_WIG); bf16* Wbr = (bf16*)(ws + WS_WBR); bf16* Wout = (bf16*)(ws + WS_WOUT); bf16* Wgu = (bf16*)(ws + WS_WGU); bf16* Wdn = (bf16*)(ws + WS_WDN);
    const float* w_in = a.in[2] + (size_t)l * DM * D_IN;
    const float* w_gate = a.in[16] + (size_t)l * DM * D_QKV;
    const float* w_bsb = a.in[13] + (size_t)l * D_SB * DM;
    const float* w_bdf = a.in[14] + (size_t)l * D_DIFF * DM;
    const float* w_bfx = a.in[15] + (size_t)l * D_FOX * DM;
    const float* w_out = a.in[17] + (size_t)l * DM * DM;
    const float* w_fg = a.in[19] + (size_t)l * DM * D_FF;
    const float* w_fu = a.in[20] + (size_t)l * DM * D_FF;
    const float* w_fd = a.in[21] + (size_t)l * D_FF * DM;
    constexpr int I_IN = (DM / 64) * (D_QKV / 32);
    constexpr int I_SB = (D_SB / 64) * (DM / 32);
    constexpr int I_DF = (D_DIFF / 64) * (DM / 32);
    constexpr int I_OUT = (DM / 64) * (DM / 32);
    constexpr int I_FF = (DM / 64) * (D_FF / 32);
    constexpr int I_DN = (D_FF / 64) * (DM / 32);
    constexpr int NITEMS = 2 * I_IN + I_SB + 2 * I_DF + I_OUT + 2 * I_FF + I_DN;
    for (int it = gw; it < NITEMS; it += NGW) {
        int r = it; const float* W; int ld, K, N, mode = 0, ldt = 0, nm = 0; bf16* WT;
        if (r < I_IN) { W = w_in; ld = D_IN; K = DM; N = D_QKV; WT = Wig; nm = 1; }
        else if ((r -= I_IN) < I_IN) { W = w_gate; ld = D_QKV; K = DM; N = D_QKV; WT = Wig + (size_t)D_QKV * DM; nm = 1; }
        else if ((r -= I_IN) < I_SB) { W = w_bsb; ld = DM; K = D_SB; N = DM; WT = Wbr; ldt = DM; }
        else if ((r -= I_SB) < I_DF) { W = w_bdf; ld = DM; K = D_DIFF; N = DM; WT = Wbr + (size_t)DM * DM; ldt = DM; }
        else if ((r -= I_DF) < I_DF) { W = w_bfx; ld = DM; K = D_FOX; N = DM; WT = Wbr + (size_t)2 * DM * DM; ldt = DM; }
        else if ((r -= I_DF) < I_OUT) { W = w_out; ld = DM; K = DM; N = DM; WT = Wout; }
        else if ((r -= I_OUT) < I_FF) { W = w_fg; ld = D_FF; K = DM; N = D_FF; WT = Wgu; mode = 1; }
        else if ((r -= I_FF) < I_FF) { W = w_fu; ld = D_FF; K = DM; N = D_FF; WT = Wgu; mode = 2; }
        else { r -= I_FF; W = w_fd; ld = DM; K = D_FF; N = DM; WT = Wdn; }
        const int nb = N / 32, kb = r / nb, n0 = (r % nb) * 32;
        const int drow0 = mode == 0 ? n0 : (n0 >> 7) * 256 + (n0 & 127) + (mode == 2 ? 128 : 0);
        transpose_item(W, ld, ldt ? ldt : K, WT, kb * 64, n0, drow0, scr, lane, mode ? a.in[18] + l * DM : (nm ? a.in[1] + l * DM : nullptr));
    }
}
template <bool FORGET>
__device__ __forceinline__ void phase_rmsnorm(const float* x, const bf16* xb, bf16* xb_out, const float* g, float* rstd_out, const LAS float* wf, const float* bfg, float* logf, int wave, int lane, int vcu, int G) {
    const int gw = vcu * NWAVES + wave, NGW = G * NWAVES;
    f32x4 gv[8];
#pragma unroll
    for (int j = 0; j < 8; ++j) gv[j] = *(const f32x4*)(g + 4 * lane + 256 * j);
    for (int m = gw; m < M; m += NGW) {
        f32x4 v[8]; float s = 0.f;
        if (x) {
            const GAS f32x4* xr = (const GAS f32x4*)(x + (size_t)m * DM) + lane;
#pragma unroll
            for (int j = 0; j < 8; ++j) v[j] = xr[64 * j];
            GAS unsigned long long* x8 = (GAS unsigned long long*)(xb_out + (size_t)m * DM) + lane;
#pragma unroll
            for (int j = 0; j < 8; ++j) { const unsigned lo = pk2(v[j].x, v[j].y), hi = pk2(v[j].z, v[j].w); x8[64 * j] = (unsigned long long)lo | ((unsigned long long)hi << 32);
                v[j] = (f32x4){bflo(lo), bfhi(lo), bflo(hi), bfhi(hi)}; }
        } else {
            const GAS unsigned long long* xr = (const GAS unsigned long long*)(xb + (size_t)m * DM) + lane;
            unsigned long long t[8];
#pragma unroll
            for (int j = 0; j < 8; ++j) t[j] = xr[64 * j];
#pragma unroll
            for (int j = 0; j < 8; ++j) { const unsigned lo = (unsigned)t[j], hi = (unsigned)(t[j] >> 32); v[j] = (f32x4){bflo(lo), bfhi(lo), bflo(hi), bfhi(hi)}; }
        }
#pragma unroll
        for (int j = 0; j < 8; ++j) s += (v[j].x * v[j].x + v[j].y * v[j].y) + (v[j].z * v[j].z + v[j].w * v[j].w);
        const float rstd = 1.0f / sqrtf(wave_sum(s) * (1.f / DM) + EPS);
#pragma unroll
        for (int j = 0; j < 8; ++j) v[j] = v[j] * rstd * gv[j];
        if (lane == 0) rstd_out[m] = rstd;
        if constexpr (FORGET) {
            float d[5];
#pragma unroll
            for (int h = 0; h < 5; ++h) { float p = 0.f;
#pragma unroll
                for (int j = 0; j < 8; ++j) { const f32x4 w = *(const LAS f32x4*)(wf + h * DM + 4 * lane + 256 * j); p += (v[j].x * w.x + v[j].y * w.y) + (v[j].z * w.z + v[j].w * w.w); }
                d[h] = wave_sum(p); asm volatile("" ::: "memory"); }
            if (lane < 5) { float dv = d[0]; dv = lane == 1 ? d[1] : dv; dv = lane == 2 ? d[2] : dv; dv = lane == 3 ? d[3] : dv; dv = lane == 4 ? d[4] : dv;
                const int b = m / SEQ, s_ = m % SEQ; logf[(size_t)(b * H_FOX + lane) * SEQ + s_] = logsigmoidf(dv + bfg[lane]); }
        }
    }
}

namespace att {
typedef short bf16x8 __attribute__((ext_vector_type(8)));
typedef short s16x4 __attribute__((ext_vector_type(4)));
typedef float f32x16 __attribute__((ext_vector_type(16)));
typedef float f32x4 __attribute__((ext_vector_type(4)));
typedef unsigned u32x4 __attribute__((ext_vector_type(4)));
constexpr int SHM = 16384;
constexpr int L_V = 0, L_K = 2 * SHM, L_BIAS = 4 * SHM, L_WS = L_BIAS + 512, L_FLAG = L_WS + 8 * 256, L_QW = L_FLAG + 128, L_QF = L_QW + 64  , L_END = L_QF + 8 * 4096;
constexpr float LOG2E = 1.4426950408889634f, LN2 = 0.6931471805599453f;
enum { MODE_SB = 0, MODE_DIFF = 1, MODE_FOX = 2 };

__device__ __forceinline__ int kswz(int row, int colB) { return row * 256 + (colB ^ ((row & 7) << 4)); }
__device__ __forceinline__ int v_st(int k, int c) { const int kk = (k & ~0xC) | ((k & 4) << 1) | ((k & 8) >> 1); return ((kk >> 3) * 4 + (c >> 5)) * 512 + ((kk & 7) * 32 + (c & 31)) * 2; }
__device__ __forceinline__ int v_rd_base(int lane) { return ((lane & 3) << 3) | (((lane >> 2) & 3) << 6) | (((lane >> 4) & 1) << 5) | (((lane >> 5) & 1) << 8); }
constexpr int v_rd_off(int d0, int ks, int half) { return d0 * 512 + ks * 4096 + half * 2048; }
__device__ __forceinline__ int crow(int r, int hi) { return (r & 3) + 8 * (r >> 2) + 4 * hi; }
__device__ __forceinline__ unsigned cvtpk(float lo, float hi) { unsigned r; asm volatile("v_cvt_pk_bf16_f32 %0, %1, %2" : "=v"(r) : "v"(lo), "v"(hi)); return r; }
__device__ __forceinline__ void unpack8(bf16x8 v, float* a) { const u32x4 w = __builtin_bit_cast(u32x4, v);
    a[0] = __uint_as_float(w.x << 16); a[1] = __uint_as_float(w.x & 0xffff0000u); a[2] = __uint_as_float(w.y << 16); a[3] = __uint_as_float(w.y & 0xffff0000u);
    a[4] = __uint_as_float(w.z << 16); a[5] = __uint_as_float(w.z & 0xffff0000u); a[6] = __uint_as_float(w.w << 16); a[7] = __uint_as_float(w.w & 0xffff0000u); }
__device__ __forceinline__ bf16x8 pack8f(const float* a) { u32x4 w = {cvtpk(a[0], a[1]), cvtpk(a[2], a[3]), cvtpk(a[4], a[5]), cvtpk(a[6], a[7])}; return __builtin_bit_cast(bf16x8, w); }
__device__ __forceinline__ float swap_max(float v) { auto rr = __builtin_amdgcn_permlane32_swap(__float_as_uint(v), __float_as_uint(v), false, false); return fmaxf(__uint_as_float(rr[0]), __uint_as_float(rr[1])); }
__device__ __forceinline__ float swap_add(float v) { auto rr = __builtin_amdgcn_permlane32_swap(__float_as_uint(v), __float_as_uint(v), false, false); return __uint_as_float(rr[0]) + __uint_as_float(rr[1]); }
template <int CTRL> __device__ __forceinline__ float dpp_mov(float v) { return __builtin_bit_cast(float, __builtin_amdgcn_update_dpp(0, __builtin_bit_cast(int, v), CTRL, 0xf, 0xf, true)); }
__device__ __forceinline__ float sum8(float v) { v += dpp_mov<0xB1>(v); v += dpp_mov<0x4E>(v); v += dpp_mov<0x141>(v); return v; }
__device__ __forceinline__ float sum16(float v) { v = sum8(v); v += dpp_mov<0x140>(v); return v; }
__device__ __forceinline__ float sum32(float v) { v = sum16(v); v += __builtin_bit_cast(float, __builtin_amdgcn_ds_swizzle(__builtin_bit_cast(int, v), 0x401F)); return v; }

template <int ND0, bool INIT = false>
__device__ __forceinline__ void qkt(f32x16& p0, f32x16& p1, const LAS unsigned char* Kb, int d0lo, int r32, int hi, const bf16x8* qr) {
    if (!INIT) {
#pragma unroll
        for (int r = 0; r < 16; ++r) { p0[r] = 0.f; p1[r] = 0.f; } }
#pragma unroll
    for (int d = 0; d < ND0; ++d) { const LAS unsigned char* a = Kb + kswz(r32, (d0lo + d) * 32 + hi * 16);
        const bf16x8 b0 = *(const LAS bf16x8*)a, b1 = *(const LAS bf16x8*)(a + 32 * 256);
        p0 = __builtin_amdgcn_mfma_f32_32x32x16_bf16(b0, qr[d], p0, 0, 0, 0);
        p1 = __builtin_amdgcn_mfma_f32_32x32x16_bf16(b1, qr[d], p1, 0, 0, 0); }
}
template <int ND0>
__device__ __forceinline__ void qkt_lq(f32x16& p0, f32x16& p1, const LAS unsigned char* Kb, int d0lo, int r32, int hi, const LAS unsigned char* qf) {
#pragma unroll
    for (int d = 0; d < ND0; ++d) { const LAS unsigned char* a = Kb + kswz(r32, (d0lo + d) * 32 + hi * 16);
        const bf16x8 b0 = *(const LAS bf16x8*)a, b1 = *(const LAS bf16x8*)(a + 32 * 256), q = *(const LAS bf16x8*)(qf + d * 1024);
        p0 = __builtin_amdgcn_mfma_f32_32x32x16_bf16(b0, q, p0, 0, 0, 0);
        p1 = __builtin_amdgcn_mfma_f32_32x32x16_bf16(b1, q, p1, 0, 0, 0); }
}
__device__ __forceinline__ void pv_tile(f32x16* o, int vb, bf16x8 pa0, bf16x8 pa1, bf16x8 pa2, bf16x8 pa3) {
#define TRRD(dst, off) asm volatile("ds_read_b64_tr_b16 %0, %1 offset:%2" : "=&v"(dst) : "v"(vb), "i"(off) : "memory")
#define PV_D0(d0) do { s16x4 l0, l1, l2, l3, h0, h1, h2, h3; constexpr int b_ = v_rd_off(d0, 0, 0); \
        TRRD(l0, b_); TRRD(h0, b_ + 2048); TRRD(l1, b_ + 4096); TRRD(h1, b_ + 6144); TRRD(l2, b_ + 8192); TRRD(h2, b_ + 10240); TRRD(l3, b_ + 12288); TRRD(h3, b_ + 14336); \
        asm volatile("s_waitcnt lgkmcnt(0)" ::: "memory"); __builtin_amdgcn_sched_barrier(0); \
        o[d0] = __builtin_amdgcn_mfma_f32_32x32x16_bf16(pa0, (bf16x8){l0[0], l0[1], l0[2], l0[3], h0[0], h0[1], h0[2], h0[3]}, o[d0], 0, 0, 0); \
        o[d0] = __builtin_amdgcn_mfma_f32_32x32x16_bf16(pa1, (bf16x8){l1[0], l1[1], l1[2], l1[3], h1[0], h1[1], h1[2], h1[3]}, o[d0], 0, 0, 0); \
        o[d0] = __builtin_amdgcn_mfma_f32_32x32x16_bf16(pa2, (bf16x8){l2[0], l2[1], l2[2], l2[3], h2[0], h2[1], h2[2], h2[3]}, o[d0], 0, 0, 0); \
        o[d0] = __builtin_amdgcn_mfma_f32_32x32x16_bf16(pa3, (bf16x8){l3[0], l3[1], l3[2], l3[3], h3[0], h3[1], h3[2], h3[3]}, o[d0], 0, 0, 0); } while (0)
    PV_D0(0); PV_D0(1); PV_D0(2); PV_D0(3);
#undef PV_D0
#undef TRRD
}
__device__ __forceinline__ void pack_p(const f32x16& p0, const f32x16& p1, bf16x8& pa0, bf16x8& pa1, bf16x8& pa2, bf16x8& pa3) {
#define PK4(P, B_, OUT) do { unsigned a0 = cvtpk(P[B_ + 0], P[B_ + 1]), a1 = cvtpk(P[B_ + 2], P[B_ + 3]); \
        unsigned b0 = cvtpk(P[B_ + 4], P[B_ + 5]), b1 = cvtpk(P[B_ + 6], P[B_ + 7]); \
        auto r0 = __builtin_amdgcn_permlane32_swap(a0, b0, false, false); auto r1 = __builtin_amdgcn_permlane32_swap(a1, b1, false, false); \
        u32x4 w = {r0[0], r1[0], r0[1], r1[1]}; OUT = __builtin_bit_cast(bf16x8, w); } while (0)
    PK4(p0, 0, pa0); PK4(p0, 8, pa1); PK4(p1, 0, pa2); PK4(p1, 8, pa3);
#undef PK4
}

struct Stage { bf16x8 k0, k1, v0, v1; float bias; };
template <int MODE> __device__ __forceinline__ void st_load(Stage& S, const bf16* Kg, const bf16* Vg, const float* cu, int j, int sr, int sc, int tid) {
    const size_t r0 = (size_t)(64 * j + sr) * HLD + sc, r1 = r0 + (size_t)32 * HLD;
    S.k0 = *(const GAS bf16x8*)(Kg + r0); S.k1 = *(const GAS bf16x8*)(Kg + r1);
    S.v0 = *(const GAS bf16x8*)(Vg + r0); S.v1 = *(const GAS bf16x8*)(Vg + r1);
    if (MODE == MODE_FOX) { if (tid < 64) S.bias = cu[64 * j + tid]; }
}
__device__ __forceinline__ float min32(float v) { v = fminf(v, dpp_mov<0xB1>(v)); v = fminf(v, dpp_mov<0x4E>(v)); v = fminf(v, dpp_mov<0x141>(v)); v = fminf(v, dpp_mov<0x140>(v));
    return fminf(v, __builtin_bit_cast(float, __builtin_amdgcn_ds_swizzle(__builtin_bit_cast(int, v), 0x401F))); }
template <int MODE> __device__ __forceinline__ bf16x8 knorm(bf16x8 k) {
    if (MODE == MODE_SB) return k;
    float a[8]; unpack8(k, a);
    float ss = (a[0] * a[0] + a[1] * a[1]) + (a[2] * a[2] + a[3] * a[3]) + (a[4] * a[4] + a[5] * a[5]) + (a[6] * a[6] + a[7] * a[7]);
    ss = (MODE == MODE_FOX) ? sum16(ss) : sum8(ss);
    const float rs = __builtin_amdgcn_rsqf(ss * (MODE == MODE_FOX ? (1.f / 128.f) : (1.f / 64.f)) + EPS);
#pragma unroll
    for (int i = 0; i < 8; ++i) a[i] *= rs;
    return pack8f(a);
}
template <int MODE> __device__ __forceinline__ void st_write(const Stage& S, LAS unsigned char* lds, int buf, int kws, int vst0, int vst1, int tid) {
    const bf16x8 k0 = S.k0, k1 = S.k1;
    *(LAS bf16x8*)(lds + L_K + buf * SHM + kws) = k0; *(LAS bf16x8*)(lds + L_K + buf * SHM + kws + 32 * 256) = k1;
    *(LAS bf16x8*)(lds + L_V + buf * SHM + vst0) = S.v0; *(LAS bf16x8*)(lds + L_V + buf * SHM + vst1) = S.v1;
    if (MODE == MODE_FOX) { if (tid < 64) ((LAS float*)(lds + L_BIAS))[buf * 64 + tid] = -S.bias * LOG2E; }
}

__device__ __forceinline__ void st_load_diff(Stage& S, const bf16* Kg, const bf16* Vg, int j, int sr, int sc, int kr, int kc) {
    const size_t r0 = (size_t)(64 * j + sr) * HLD + sc, r1 = r0 + (size_t)32 * HLD;
    S.k0 = *(const GAS bf16x8*)(Kg + (size_t)(64 * j + kr) * HLD + kc);
    S.v0 = *(const GAS bf16x8*)(Vg + r0); S.v1 = *(const GAS bf16x8*)(Vg + r1);
}
__device__ __forceinline__ void st_write_diff(const Stage& S, LAS unsigned char* lds, int buf, int kwd, int vst0, int vst1) {
    *(LAS bf16x8*)(lds + L_K + buf * SHM + kwd) = S.k0;
    *(LAS bf16x8*)(lds + L_V + buf * SHM + vst0) = S.v0; *(LAS bf16x8*)(lds + L_V + buf * SHM + vst1) = S.v1;
}
__device__ __forceinline__ void softmax_step(f32x16& p0, f32x16& p1, float& m_run, float& l_run, f32x16* o, LAS float* al_l, int r32, int hi, bool first, bf16x8& pa0, bf16x8& pa1, bf16x8& pa2, bf16x8& pa3) {
    float pmax = p0[0];
#pragma unroll
    for (int r = 1; r < 16; ++r) pmax = fmaxf(pmax, p0[r]);
#pragma unroll
    for (int r = 0; r < 16; ++r) pmax = fmaxf(pmax, p1[r]);
    pmax = swap_max(pmax);
    const float shift = first ? pmax : fmaxf(pmax, 0.f);
    const float alpha = first ? 1.f : __builtin_amdgcn_exp2f(-shift);
    m_run += shift;
    if (__any(shift != 0.f)) {
        if (hi == 0) al_l[r32] = alpha;
#pragma unroll
        for (int r = 0; r < 16; ++r) { p0[r] -= shift; p1[r] -= shift; }
        asm volatile("s_waitcnt lgkmcnt(0)" ::: "memory");
#pragma unroll
        for (int g = 0; g < 4; ++g) { const f32x4 f = *(const LAS f32x4*)(al_l + 8 * g + 4 * hi);
#pragma unroll
            for (int d = 0; d < 4; ++d)
#pragma unroll
                for (int i = 0; i < 4; ++i) o[d][4 * g + i] *= f[i]; }
    }
    float ps = 0.f;
#pragma unroll
    for (int r = 0; r < 16; ++r) { p0[r] = __builtin_amdgcn_exp2f(p0[r]); ps += p0[r]; }
#pragma unroll
    for (int r = 0; r < 16; ++r) { p1[r] = __builtin_amdgcn_exp2f(p1[r]); ps += p1[r]; }
    ps = swap_add(ps);
    l_run = l_run * alpha + ps;
    pack_p(p0, p1, pa0, pa1, pa2, pa3);
}
__device__ __forceinline__ void row_table(float x, LAS float* tb, int r32, int hi, float* f) {
    if (hi == 0) tb[r32] = x;
    asm volatile("s_waitcnt lgkmcnt(0)" ::: "memory");
#pragma unroll
    for (int g = 0; g < 4; ++g) { const f32x4 v = *(const LAS f32x4*)(tb + 8 * g + 4 * hi); f[4 * g + 0] = v[0]; f[4 * g + 1] = v[1]; f[4 * g + 2] = v[2]; f[4 * g + 3] = v[3]; }
    asm volatile("s_waitcnt lgkmcnt(0)" ::: "memory");
}
__device__ __forceinline__ void store_o(const f32x16* o, bf16* Ow, int r32, int hi) {
#pragma unroll
    for (int r = 0; r < 16; ++r) { const int orow = crow(r, hi);
#pragma unroll
        for (int d0 = 0; d0 < 4; ++d0) { const float v = o[d0][r]; const float vn = dpp_mov<0xB1>(v);
            if ((r32 & 1) == 0) *(GAS unsigned*)(Ow + (size_t)orow * DM + d0 * 32 + r32) = cvtpk(v, vn); } }
}

struct UnitP { const bf16* H; bf16* O; const float* cum; float* stash; const float* gq; const float* gk; const float* subg; float lam, one_m_li; };

__device__ __forceinline__ void unit_fox(const UnitP& P, int b, int h, int qb, LAS unsigned char* lds) {
    int tid = threadIdx.x; asm volatile("" : "+v"(tid));
    const int wid = __builtin_amdgcn_readfirstlane(tid >> 6), lane = tid & 63, r32 = lane & 31, hi = lane >> 5;
    const int q0 = qb * 256, trow = q0 + 32 * wid + r32, tmin = q0 + 32 * wid; const size_t rb = (size_t)b * SEQ;
    const bf16* Kg = P.H + hslot(KC + h * HD) + rb * HLD; const bf16* Vg = P.H + hslot(VC + h * HD) + rb * HLD; const bf16* Qg = P.H + hslot(QC + h * HD) + (rb + trow) * HLD;
    const float* cu = P.cum + (size_t)(b * H_FOX + h) * SEQ;
    const int sr = tid >> 4, sc = (tid & 15) * 8, kws = kswz(sr, sc * 2), vst0 = v_st(sr, sc), vst1 = v_st(32 + sr, sc);
    const int vb0 = (int)(uintptr_t)(lds + L_V) + v_rd_base(lane);
    LAS float* wsf = (LAS float*)(lds + L_WS) + wid * 64;
    bf16x8 qr[8];
    { float ss = 0.f;
#pragma unroll
      for (int d0 = 0; d0 < 8; ++d0) { qr[d0] = *(const GAS bf16x8*)(Qg + d0 * 16 + hi * 8); float a[8]; unpack8(qr[d0], a);
#pragma unroll
          for (int i = 0; i < 8; ++i) ss += a[i] * a[i]; }
      ss = swap_add(ss);
      const float rs = __builtin_amdgcn_rsqf(ss * (1.f / 128.f) + EPS) * (0.08838834764831845f * LOG2E);
#pragma unroll
      for (int d0 = 0; d0 < 8; ++d0) { float a[8]; unpack8(qr[d0], a); const int d = d0 * 16 + hi * 8;
          const f32x4 g0 = *(const f32x4*)(P.gq + d), g1 = *(const f32x4*)(P.gq + d + 4), k0 = *(const f32x4*)(P.gk + d), k1 = *(const f32x4*)(P.gk + d + 4);
#pragma unroll
          for (int i = 0; i < 4; ++i) { a[i] *= rs * g0[i] * k0[i]; a[4 + i] *= rs * g1[i] * k1[i]; }
          qr[d0] = pack8f(a); } }
    float m_run = 0.f, l_run = 0.f; f32x16 o[4];
#pragma unroll
    for (int d = 0; d < 4; ++d)
#pragma unroll
        for (int r = 0; r < 16; ++r) o[d][r] = 0.f;
    const int NT = 4 * qb + 4, jw = (tmin + 31) >> 6;
    Stage SA, SB; st_load<MODE_FOX>(SA, Kg, Vg, cu, NT - 1, sr, sc, tid); st_write<MODE_FOX>(SA, lds, 0, kws, vst0, vst1, tid);
    __syncthreads();
    st_load<MODE_FOX>(SA, Kg, Vg, cu, NT - 2, sr, sc, tid);
    const int i0 = NT - 1 - jw;
#define FOX_COMPUTE(j_, buf_) do { \
            f32x16 p0, p1; \
            const LAS float* bb = (const LAS float*)(lds + L_BIAS) + (buf_) * 64 + 4 * hi; \
            _Pragma("unroll") for (int g = 0; g < 4; ++g) { const f32x4 x = *(const LAS f32x4*)(bb + 8 * g), y = *(const LAS f32x4*)(bb + 32 + 8 * g); \
                _Pragma("unroll") for (int i2 = 0; i2 < 4; ++i2) { p0[4 * g + i2] = x[i2] - m_run; p1[4 * g + i2] = y[i2] - m_run; } } \
            qkt<8, true>(p0, p1, lds + L_K + (buf_) * SHM, 0, r32, hi, qr); \
            if (64 * (j_) + 63 > tmin) { const int dq = trow - 64 * (j_) - 4 * hi; const float NEG = -__builtin_inff(); \
                _Pragma("unroll") for (int r = 0; r < 16; ++r) { const int c = (r & 3) + 8 * (r >> 2); if (c > dq) p0[r] = NEG; if (c + 32 > dq) p1[r] = NEG; } } \
            bf16x8 pa0, pa1, pa2, pa3; \
            softmax_step(p0, p1, m_run, l_run, o, wsf, r32, hi, (j_) == jw, pa0, pa1, pa2, pa3); \
            pv_tile(o, vb0 + (buf_) * SHM, pa0, pa1, pa2, pa3); } while (0)
    for (int i = 0; i < NT; i += 2) {
        { const int j = NT - 1 - i;
          if (i + 2 < NT) st_load<MODE_FOX>(SB, Kg, Vg, cu, j - 2, sr, sc, tid);
          if (i >= i0) FOX_COMPUTE(j, 0);
          st_write<MODE_FOX>(SA, lds, 1, kws, vst0, vst1, tid);
          __syncthreads(); }
        { const int j = NT - 2 - i;
          if (i + 3 < NT) st_load<MODE_FOX>(SA, Kg, Vg, cu, j - 2, sr, sc, tid);
          if (i + 1 >= i0) FOX_COMPUTE(j, 1);
          if (i + 2 < NT) st_write<MODE_FOX>(SB, lds, 0, kws, vst0, vst1, tid);
          __syncthreads(); }
    }
#undef FOX_COMPUTE
    float rl[16]; row_table(__builtin_amdgcn_rcpf(l_run), wsf + 32, r32, hi, rl);
#pragma unroll
    for (int d = 0; d < 4; ++d)
#pragma unroll
        for (int r = 0; r < 16; ++r) o[d][r] *= rl[r];
    store_o(o, P.O + (rb + tmin) * DM + OC + h * HD, r32, hi);
}

__device__ __forceinline__ void unit_diff(const UnitP& P, int b, int h, int qb, float slope2, LAS unsigned char* lds) {
    int tid = threadIdx.x; asm volatile("" : "+v"(tid));
    const int wid = __builtin_amdgcn_readfirstlane(tid >> 6), lane = tid & 63, r32 = lane & 31, hi = lane >> 5;
    const int q0 = qb * 256, trow = q0 + 32 * wid + r32, tmin = q0 + 32 * wid; const size_t rb = (size_t)b * SEQ;
    const bf16* Kg = P.H + hslot(KB_ + h * HD) + rb * HLD; const bf16* Vg = P.H + hslot(VB_ + h * HD) + rb * HLD; const bf16* Qg = P.H + hslot(QB_ + h * HD) + (rb + trow) * HLD;
    const int sr = tid >> 4, sc = (tid & 15) * 8, kws = kswz(sr, sc * 2), vst0 = v_st(sr, sc), vst1 = v_st(32 + sr, sc);
    const int vb0 = (int)(uintptr_t)(lds + L_V) + v_rd_base(lane);
    LAS float* wsf = (LAS float*)(lds + L_WS) + wid * 64;
    const int NT = 4 * qb + 4, jw = tmin >> 6;
    float* stash = P.stash + (size_t)blockIdx.x * 32768;
    LAS unsigned char* qf = lds + L_QF + wid * 4096 + lane * 16;
    f32x16 o[4];
    for (int mp = 0; mp < 2; ++mp) {
        bf16x8 qr[4];
        { float ss = 0.f, qn2 = 0.f;
          int tq = trow; asm volatile("" : "+v"(tq));
          const bf16* Qp = P.H + hslot(QB_ + h * HD) + (rb + tq) * HLD + mp * 64 + hi * 8;
#pragma unroll
          for (int d = 0; d < 4; ++d) { qr[d] = *(const GAS bf16x8*)(Qp + d * 16); float a[8]; unpack8(qr[d], a);
#pragma unroll
              for (int i = 0; i < 8; ++i) ss += a[i] * a[i]; }
          ss = swap_add(ss);
          const float rs = __builtin_amdgcn_rsqf(ss * (1.f / 64.f) + EPS) * (0.125f * LOG2E);
#pragma unroll
          for (int d = 0; d < 4; ++d) { float a[8]; unpack8(qr[d], a); const int dd = d * 16 + hi * 8;
              const f32x4 g0 = *(const f32x4*)(P.gq + dd), g1 = *(const f32x4*)(P.gq + dd + 4), k0 = *(const f32x4*)(P.gk + dd), k1 = *(const f32x4*)(P.gk + dd + 4);
#pragma unroll
              for (int i = 0; i < 4; ++i) { a[i] *= rs * g0[i] * k0[i]; a[4 + i] *= rs * g1[i] * k1[i]; }
#pragma unroll
              for (int i = 0; i < 8; ++i) qn2 += a[i] * a[i];
              *(LAS bf16x8*)(qf + d * 1024) = pack8f(a); }
          qn2 = swap_add(qn2);
          const float need = (152.0f + 16.4f * sqrtf(qn2)) / slope2;
          const float smin = min32((float)trow - need);
          if (lane == 0) ((LAS float*)(lds + L_FLAG))[16 + wid] = smin; }
        float m_run = 0.f, l_run = 0.f;
#pragma unroll
        for (int d = 0; d < 4; ++d)
#pragma unroll
            for (int r = 0; r < 16; ++r) o[d][r] = 0.f;
        const int kr = tid >> 3, kc = mp * 64 + (tid & 7) * 8, kwd = kswz(kr, kc * 2);
        Stage S; st_load_diff(S, Kg, Vg, NT - 1, sr, sc, kr, kc); st_write_diff(S, lds, 0, kwd, vst0, vst1);
        __syncthreads();
        int jlo;
        { const LAS f32x4* f4 = (const LAS f32x4*)((LAS float*)(lds + L_FLAG) + 16); const f32x4 fa = f4[0], fb = f4[1];
          const float sm = fminf(fminf(fminf(fa[0], fa[1]), fminf(fa[2], fa[3])), fminf(fminf(fb[0], fb[1]), fminf(fb[2], fb[3])));
          jlo = __builtin_amdgcn_readfirstlane((int)(fmaxf(sm, 0.f) * (1.0f / 64.0f))); if (jlo > NT - 4) jlo = NT - 4; }
        const int NE = NT - jlo;
        const int i0 = NT - 1 - jw;
        for (int i = 0; i < i0; ++i) {
            const int buf = i & 1, j = NT - 1 - i;
            st_load_diff(S, Kg, Vg, j - 1, sr, sc, kr, kc);
            st_write_diff(S, lds, buf ^ 1, kwd, vst0, vst1);
            __syncthreads();
        }
        for (int i = i0; i < NE; ++i) {
            const int buf = i & 1, j = NT - 1 - i;
            if (i + 1 < NE) st_load_diff(S, Kg, Vg, j - 1, sr, sc, kr, kc);
            {
                f32x16 p0, p1;
                const float dq = (float)(trow - 64 * j - 4 * hi);
                const float nm = -m_run;
#pragma unroll
                for (int r = 0; r < 16; ++r) { const float c = (float)((r & 3) + 8 * (r >> 2)); p0[r] = fmaf(-slope2, fabsf(dq - c), nm); p1[r] = fmaf(-slope2, fabsf(dq - (c + 32.f)), nm); }
                qkt_lq<4>(p0, p1, lds + L_K + buf * SHM, mp * 4, r32, hi, qf);
                bf16x8 pa0, pa1, pa2, pa3;
                softmax_step(p0, p1, m_run, l_run, o, wsf, r32, hi, j == jw, pa0, pa1, pa2, pa3);
                pv_tile(o, vb0 + buf * SHM, pa0, pa1, pa2, pa3);
            }
            if (i + 1 < NE) st_write_diff(S, lds, buf ^ 1, kwd, vst0, vst1);
            __syncthreads();
        }
        float rl[16]; row_table(__builtin_amdgcn_rcpf(l_run), wsf + 32, r32, hi, rl);
        int tso = tid; asm volatile("" : "+v"(tso));
        GAS char* stp = (GAS char*)stash + (size_t)tso * 16;
        if (mp == 0) {
#pragma unroll
            for (int d = 0; d < 4; ++d)
#pragma unroll
                for (int g = 0; g < 4; ++g) { f32x4 v; v[0] = o[d][4 * g] * rl[4 * g]; v[1] = o[d][4 * g + 1] * rl[4 * g + 1]; v[2] = o[d][4 * g + 2] * rl[4 * g + 2]; v[3] = o[d][4 * g + 3] * rl[4 * g + 3];
                    *(GAS f32x4*)stp = v; stp += 8192; asm volatile("" : "+v"(stp)); }
        } else {
#pragma unroll
            for (int d = 0; d < 4; ++d)
#pragma unroll
                for (int g = 0; g < 4; ++g) { const f32x4 v = *(const GAS f32x4*)stp; stp += 8192; asm volatile("" : "+v"(stp));
#pragma unroll
                    for (int i = 0; i < 4; ++i) o[d][4 * g + i] = v[i] - P.lam * (o[d][4 * g + i] * rl[4 * g + i]); }
        }
    }
    const f32x4 sg = (f32x4){P.subg[r32], P.subg[32 + r32], P.subg[64 + r32], P.subg[96 + r32]} * P.one_m_li;
#pragma unroll
    for (int r = 0; r < 16; ++r) { float s = (o[0][r] * o[0][r] + o[1][r] * o[1][r]) + (o[2][r] * o[2][r] + o[3][r] * o[3][r]);
        s = sum32(s);
        const float rs = __builtin_amdgcn_rsqf(s * (1.f / 128.f) + EPS);
        o[0][r] *= rs * sg[0]; o[1][r] *= rs * sg[1]; o[2][r] *= rs * sg[2]; o[3][r] *= rs * sg[3]; }
    store_o(o, P.O + (rb + tmin) * DM + OB + h * HD, r32, hi);
}

__device__ __forceinline__ void unit_sb(const UnitP& P, int b, int h, int qb, LAS unsigned char* lds) {
    int tid = threadIdx.x; asm volatile("" : "+v"(tid));
    const int wid = __builtin_amdgcn_readfirstlane(tid >> 6), lane = tid & 63, r32 = lane & 31, hi = lane >> 5;
    const int q0 = qb * 256, trow = q0 + 32 * wid + r32, tmin = q0 + 32 * wid; const size_t rb = (size_t)b * SEQ;
    const bf16* Kg = P.H + hslot(KA + h * HD) + rb * HLD; const bf16* Vg = P.H + hslot(VA + h * HD) + rb * HLD; const bf16* Qg = P.H + hslot(QA + h * HD) + (rb + trow) * HLD;
    const int sr = tid >> 4, sc = (tid & 15) * 8, kws = kswz(sr, sc * 2), vst0 = v_st(sr, sc), vst1 = v_st(32 + sr, sc);
    const int vb0 = (int)(uintptr_t)(lds + L_V) + v_rd_base(lane);
    LAS unsigned* flags = (LAS unsigned*)(lds + L_FLAG);
    bf16x8 qr[8];
#pragma unroll
    for (int d0 = 0; d0 < 8; ++d0) qr[d0] = *(const GAS bf16x8*)(Qg + d0 * 16 + hi * 8);
    f32x16 o[4];
#pragma unroll
    for (int d = 0; d < 4; ++d)
#pragma unroll
        for (int r = 0; r < 16; ++r) o[d][r] = 0.f;
    const int jtop = 4 * qb + 3, NT = jtop + 1;
    const int jw = (tmin + 30) >> 6;
    float carry = 0.f; bool done = false;
    Stage S; st_load<MODE_SB>(S, Kg, Vg, nullptr, jtop, sr, sc, tid); st_write<MODE_SB>(S, lds, 0, kws, vst0, vst1, tid);
    __syncthreads();
    for (int i = 0; i < NT; ++i) {
        const int buf = i & 1, j = jtop - i;
        if (i + 1 < NT) st_load<MODE_SB>(S, Kg, Vg, nullptr, j - 1, sr, sc, tid);
        if (j <= jw && !done) {
            f32x16 z0, z1; qkt<8>(z0, z1, lds + L_K + buf * SHM, 0, r32, hi, qr);
            const int dq = trow - 64 * j - 4 * hi;
            const bool need_mask = 64 * j + 63 >= tmin;
            f32x16 l0, l1;
            typedef float f32x2_ __attribute__((ext_vector_type(2)));
            constexpr float CS = 0.08838834764831845f * LOG2E;
#pragma unroll
            for (int r = 0; r < 16; r += 2) { const int c = (r & 3) + 8 * (r >> 2);
                const f32x2_ u0 = (f32x2_){z0[r], z0[r + 1]} * CS, u1 = (f32x2_){z1[r], z1[r + 1]} * CS;
                const f32x2_ d0 = (f32x2_){__builtin_amdgcn_exp2f(-fabsf(u0.x)), __builtin_amdgcn_exp2f(-fabsf(u0.y))} + 1.0f, d1 = (f32x2_){__builtin_amdgcn_exp2f(-fabsf(u1.x)), __builtin_amdgcn_exp2f(-fabsf(u1.y))} + 1.0f;
                f32x2_ s0 = (f32x2_){fmaxf(u0.x, 0.f), fmaxf(u0.y, 0.f)} + (f32x2_){__builtin_amdgcn_logf(d0.x), __builtin_amdgcn_logf(d0.y)};
                f32x2_ s1 = (f32x2_){fmaxf(u1.x, 0.f), fmaxf(u1.y, 0.f)} + (f32x2_){__builtin_amdgcn_logf(d1.x), __builtin_amdgcn_logf(d1.y)};
                if (need_mask) { if (!(c < dq)) s0.x = 0.f; if (!(c + 1 < dq)) s0.y = 0.f; if (!(c + 32 < dq)) s1.x = 0.f; if (!(c + 33 < dq)) s1.y = 0.f; }
                z0[r] = u0.x; z0[r + 1] = u0.y; z1[r] = u1.x; z1[r + 1] = u1.y;
                l0[r] = -s0.x; l0[r + 1] = -s0.y; l1[r] = -s1.x; l1[r + 1] = -s1.y; }
            float run = carry;
#pragma unroll
            for (int mm = 7; mm >= 0; --mm) {
                float t;
                if (mm >= 4) { const int m = mm - 4; t = (l1[4 * m] + l1[4 * m + 1]) + (l1[4 * m + 2] + l1[4 * m + 3]); } else { t = (l0[4 * mm] + l0[4 * mm + 1]) + (l0[4 * mm + 2] + l0[4 * mm + 3]); }
                auto rr = __builtin_amdgcn_permlane32_swap(__float_as_uint(t), __float_as_uint(t), false, false);
                const float T0 = __uint_as_float(rr[0]), T1 = __uint_as_float(rr[1]);
                const float e1 = run, e0 = run + T1; float ex = hi ? e1 : e0; run = e0 + T0;
                if (mm >= 4) { const int m = mm - 4;
#pragma unroll
                    for (int i2 = 3; i2 >= 0; --i2) { ex += l1[4 * m + i2]; l1[4 * m + i2] = ex; } }
                else {
#pragma unroll
                    for (int i2 = 3; i2 >= 0; --i2) { ex += l0[4 * mm + i2]; l0[4 * mm + i2] = ex; } }
            }
            carry = run;
#pragma unroll
            for (int r = 0; r < 16; r += 2) { const int c = (r & 3) + 8 * (r >> 2);
                const f32x2_ t0 = (f32x2_){z0[r], z0[r + 1]} + (f32x2_){l0[r], l0[r + 1]}, t1 = (f32x2_){z1[r], z1[r + 1]} + (f32x2_){l1[r], l1[r + 1]};
                float w0 = __builtin_amdgcn_exp2f(t0.x), w0b = __builtin_amdgcn_exp2f(t0.y), w1 = __builtin_amdgcn_exp2f(t1.x), w1b = __builtin_amdgcn_exp2f(t1.y);
                if (need_mask) { if (!(c < dq)) w0 = 0.f; if (!(c + 1 < dq)) w0b = 0.f; if (!(c + 32 < dq)) w1 = 0.f; if (!(c + 33 < dq)) w1b = 0.f; }
                z0[r] = w0; z0[r + 1] = w0b; z1[r] = w1; z1[r + 1] = w1b; }
            bf16x8 pa0, pa1, pa2, pa3; pack_p(z0, z1, pa0, pa1, pa2, pa3);
            pv_tile(o, vb0 + buf * SHM, pa0, pa1, pa2, pa3);
            done = __all(carry < -110.f * LOG2E);
        }
        if (lane == 0) flags[(i & 1) * 8 + wid] = (done || j == 0) ? 1u : 0u;
        if (i + 1 < NT) st_write<MODE_SB>(S, lds, buf ^ 1, kws, vst0, vst1, tid);
        __syncthreads();
        { const LAS u32x4* f4 = (const LAS u32x4*)(flags + (i & 1) * 8); const u32x4 fa = f4[0], fb = f4[1];
          if ((fa.x & fa.y & fa.z & fa.w & fb.x & fb.y & fb.z & fb.w) != 0u) break; }
    }
    store_o(o, P.O + (rb + tmin) * DM + OA + h * HD, r32, hi);
    __syncthreads();
}
}

__device__ __forceinline__ int q_pop(gu32* ctr, LAS unsigned char* lds) {
    if (threadIdx.x == 0) *(volatile LAS unsigned*)(lds + att::L_QW) = __hip_atomic_fetch_add(ctr, 1u, RLX_AGENT);
    __syncthreads();
    const unsigned v = *(volatile LAS unsigned*)(lds + att::L_QW);
    __syncthreads();
    return __builtin_amdgcn_readfirstlane((int)v);
}
__device__ __forceinline__ void attention_phase(const Args& a, int l, LAS unsigned char* lds, gu32* ctl, int rep) {
    const float lambda_init = 0.8f - 0.6f * expf(-0.3f * (float)l);
    float lam;
    { const int lane = threadIdx.x & 63; const float p1 = wave_sum(a.in[6][l * 64 + lane] * a.in[7][l * 64 + lane]), p2 = wave_sum(a.in[8][l * 64 + lane] * a.in[9][l * 64 + lane]); lam = __builtin_bit_cast(float, __builtin_amdgcn_readfirstlane(__builtin_bit_cast(int, expf(p1) - expf(p2) + lambda_init))); }
    att::UnitP P; P.H = (const bf16*)(a.ws + WS_H); P.O = (bf16*)(a.ws + WS_O); P.cum = (const float*)(a.ws + WS_CUM); P.stash = (float*)(a.ws + WS_STASH);
    P.subg = a.in[10] + l * 128; P.lam = lam; P.one_m_li = 1.0f - lambda_init;
    const int xme = (int)(xb_xcc_id() & 7u);
    gu32* qc = ctl + CW_Q + (l * 3) * 8 * 64; (void)rep;
    P.gq = a.in[4] + l * 64; P.gk = a.in[5] + l * 64;
    for (int dx = 0; dx < 8; ++dx) { const int x = (xme + dx) & 7; constexpr int NB = BATCH * H_DIFF / 8;
        for (;;) { const int li = q_pop(qc + (0 * 8 + x) * 64, lds); if (li >= NB * 8) break;
            const int qb = 7 - li / NB, bh = x + 8 * (li % NB), h = bh % H_DIFF;
            att::unit_diff(P, bh / H_DIFF, h, qb, exp2f(-8.0f * (float)(h + 1) / 5.0f) * att::LOG2E, lds); } }
    P.gq = a.in[11] + l * 128; P.gk = a.in[12] + l * 128;
    for (int dx = 0; dx < 8; ++dx) { const int x = (xme + dx) & 7; constexpr int NB = BATCH * H_FOX / 8;
        for (;;) { const int li = q_pop(qc + (1 * 8 + x) * 64, lds); if (li >= NB * 8) break;
            const int qb = 7 - li / NB, bh = x + 8 * (li % NB);
            att::unit_fox(P, bh / H_FOX, bh % H_FOX, qb, lds); } }
    for (int dx = 0; dx < 8; ++dx) { const int x = (xme + dx) & 7; constexpr int NB = BATCH * H_SB / 8;
        for (;;) { const int li = q_pop(qc + (2 * 8 + x) * 64, lds); if (li >= NB * 8) break;
            const int qb = 7 - li / NB, bh = x + 8 * (li % NB);
            att::unit_sb(P, bh / H_SB, bh % H_SB, qb, lds); } }
}

__device__ __forceinline__ void phase_scan(const float* logf, float* cum, LAS unsigned char* lds, int tid, int wave, int lane, int G) {
    LAS float* wtot = (LAS float*)(lds);
    for (int seq = blockIdx.x; seq < BATCH * H_FOX; seq += G) {
        const f32x4 v = *(const f32x4*)(logf + (size_t)seq * SEQ + 4 * tid);
        const float p0 = v.x, p1 = p0 + v.y, p2 = p1 + v.z, p3 = p2 + v.w;
        float inc = p3;
#pragma unroll
        for (int off = 1; off < 64; off <<= 1) { const float o = __shfl_up(inc, off); if (lane >= off) inc += o; }
        if (lane == 63) wtot[wave] = inc;
        LDS_WAIT(); __syncthreads();
        float base = inc - p3;
        for (int w = 0; w < wave; ++w) base += wtot[w];
        *(f32x4*)(cum + (size_t)seq * SEQ + 4 * tid) = (f32x4){base + p0, base + p1, base + p2, base + p3};
        __syncthreads();
    }
}

__global__ void __launch_bounds__(NWAVES * 64, 2) mega_fwd(Args args) {
    extern __shared__ __attribute__((aligned(16))) unsigned char lds_raw[];
    LAS unsigned char* lds = (LAS unsigned char*)lds_raw;
    volatile LAS unsigned* MISC = (volatile LAS unsigned*)(lds + MISC_OFF);
    const int G = gridDim.x; const int bx = blockIdx.x; const int vcu = (G % 8 == 0) ? (bx % 8) * (G / 8) + bx / 8 : bx;
#define TID_OPAQUE() int tid = threadIdx.x; asm volatile("" : "+v"(tid)); const int lane = tid & 63, wave = __builtin_amdgcn_readfirstlane(tid >> 6); (void)lane; (void)wave
    unsigned char* ws = args.ws;
    gu32* ctl = (gu32*)(ws + WS_CTL);
    for (int u = threadIdx.x; u < (LDS_BYTES - LDSCTL_OFF) / 4; u += NWAVES * 64) ((LAS unsigned*)(lds + LDSCTL_OFF))[u] = 0u;
    __syncthreads();
    XcdBarrier bar = xcd_barrier_post((unsigned*)(ctl + CW_BAR) + args.li * XCD_BAR_WORDS, MISC + 8);

    bf16* Wig = (bf16*)(ws + WS_WIG); bf16* Wbr = (bf16*)(ws + WS_WBR); bf16* Wout = (bf16*)(ws + WS_WOUT); bf16* Wgu = (bf16*)(ws + WS_WGU); bf16* Wdn = (bf16*)(ws + WS_WDN);
    float* logf = (float*)(ws + WS_LOGF); float* cum = (float*)(ws + WS_CUM);
    bf16* HB = (bf16*)(ws + WS_H); bf16* GB = (bf16*)(ws + WS_G); bf16* OBF = (bf16*)(ws + WS_O); bf16* YB = (bf16*)(ws + WS_Y); bf16* HFF = (bf16*)(ws + WS_HFF); bf16* XB = (bf16*)(ws + WS_XB); float* SSQ = (float*)(ws + WS_SSQ); float* RSTD = (float*)(ws + WS_RSTD);
    float* out = args.out;

    const int s_lo = args.s_lo, s_hi = args.s_hi;
#define IN(s) (s_lo <= (s) && (s) < s_hi)
#define SEAM(s) do { if (IN(s) && IN((s) + 1)) xcd_barrier(bar); } while (0)
    for (int l = 0; l < DEPTH; ++l) {
        const int sb = l * NPH;
        if (sb + NPH <= s_lo || sb >= s_hi) continue;
        if (IN(sb + 0)) for (int rep = 0; rep < (PROBE_REP == 0 ? 2 : 1); ++rep) {
            TID_OPAQUE();
            phase_convert(args, l, lds, wave, lane, vcu, G);
            __syncthreads();
            { const float* w_in = args.in[2] + (size_t)l * DM * D_IN; LAS float* wf = (LAS float*)(lds + RING_OFF);
              for (int k = tid; k < DM; k += NWAVES * 64) { const float* wr_ = w_in + (size_t)k * D_IN + D_QKV;
#pragma unroll
                  for (int h = 0; h < 5; ++h) wf[h * DM + k] = wr_[h]; }
              LDS_WAIT(); __syncthreads();
              phase_rmsnorm<true>(l == 0 ? args.in[0] : nullptr, XB, XB, args.in[1] + l * DM, RSTD, wf, args.in[3] + l * H_FOX, logf, wave, lane, vcu, G);
              __syncthreads(); }
        }
        SEAM(sb + 0);
        if (IN(sb + 1)) for (int rep = 0; rep < (PROBE_REP == 1 ? 2 : 1); ++rep) {
            { TID_OPAQUE(); phase_scan(logf, cum, lds, tid, wave, lane, G); }
            const pg8::Gemm g = pg8::mk_gemm(XB, Wig, M, D_QKV, DM, DM, DM); pg8::StaticOrder S; S.init(M, D_QKV, G, bx);
            pg8::EpiInProj E{HB, HLD, (size_t)M * HLD, (LAS float*)(lds + LDSCTL_OFF + 1024), RSTD, (LAS float*)(lds + LDSCTL_OFF + 1024 + 8192)};
            pg8::gemm_phase<pg8::EpiInProj, pg8::StaticOrder, true, true>(lds + RING_OFF, g, S, E);
        }
        SEAM(sb + 1);
        if (IN(sb + 2)) { attention_phase(args, l, lds, ctl, 0); __syncthreads(); }
        SEAM(sb + 2);
        if (IN(sb + 3)) for (int rep = 0; rep < (PROBE_REP == 3 ? 2 : 1); ++rep) {
            pg8::Gemm g = pg8::mk_gemm(XB, Wig + (size_t)D_QKV * DM, M, DM, DM, DM, DM);
            g.b_stride = DM * DM; g.A_alt = OBF + OA; g.a_off1 = OB - OA; g.a_off2 = OC - OB; g.B_alt = Wbr; g.b_stride_alt = DM * DM; g.K_alt = D_SB; g.k_dec = D_SB - D_DIFF;
            pg8::SixOrder S; S.S.init(M, DM, G, bx);
            pg8::EpiGateBranch E{GB + (size_t)bx * 65536, YB, DM, RSTD, (LAS float*)(lds + LDSCTL_OFF + 1024 + 8192)};
            pg8::gemm_phase<pg8::EpiGateBranch, pg8::SixOrder, true, true>(lds + RING_OFF, g, S, E);
        }
        SEAM(sb + 3);
        if (IN(sb + 4)) {
            const pg8::Gemm g = pg8::mk_gemm(YB, Wout, M, DM, DM, DM, DM); pg8::StaticOrder S; S.init(M, DM, G, bx);
            pg8::EpiResid E{XB, XB, nullptr, DM, SSQ, (LAS float*)(lds + LDSCTL_OFF + 1024)};
            pg8::gemm_phase<pg8::EpiResid, pg8::StaticOrder, true, true>(lds + RING_OFF, g, S, E);
        }
        SEAM(sb + 4);
        if (IN(sb + 6)) for (int rep = 0; rep < (PROBE_REP == 6 ? 2 : 1); ++rep) {
            const pg8::Gemm g = pg8::mk_gemm(XB, Wgu, M, NGU, DM, DM, DM); pg8::StaticOrder S; S.init(M, NGU, G, bx);
            pg8::EpiSwiglu E{HFF, D_FF, SSQ, (LAS float*)(lds + LDSCTL_OFF + 1024), 1.f / DM, EPS};
            pg8::gemm_phase<pg8::EpiSwiglu, pg8::StaticOrder, true, true>(lds + RING_OFF, g, S, E);
        }
        SEAM(sb + 6);
        if (IN(sb + 7)) {
            const pg8::Gemm g = pg8::mk_gemm(HFF, Wdn, M, DM, D_FF, D_FF, D_FF); pg8::StaticOrder S; S.init(M, DM, G, bx);
            pg8::EpiResid E{XB, XB, l == DEPTH - 1 ? out : nullptr, DM, nullptr, (LAS float*)(lds + LDSCTL_OFF + 1024)};
            pg8::gemm_phase<pg8::EpiResid, pg8::StaticOrder, true, true>(lds + RING_OFF, g, S, E);
        }
        SEAM(sb + 7);
    }
#undef IN
#undef SEAM
}

extern "C" void kernel_launch(void* const* d_in, const int* in_sizes, int n_in, void* d_out, int out_size, void* d_ws, size_t ws_size, hipStream_t stream) {
    static int grid = 0;
    if (grid == 0) {
        if (n_in != 22 || in_sizes[0] != M * DM || out_size != M * DM || ws_size < WS_END) {
            fprintf(stderr, "kernel_launch: unexpected shapes (n_in %d, in0 %d, out %d, ws %zu, need %zu)\n", n_in, n_in > 0 ? in_sizes[0] : -1, out_size, ws_size, (size_t)WS_END); grid = -1; return; }
        int dev = 0, cus = 0, per_cu = 0;
        if (hipGetDevice(&dev) != hipSuccess || hipDeviceGetAttribute(&cus, hipDeviceAttributeMultiprocessorCount, dev) != hipSuccess) { grid = -1; return; }
        if (hipFuncSetAttribute((const void*)mega_fwd, hipFuncAttributeMaxDynamicSharedMemorySize, LDS_BYTES) != hipSuccess) { fprintf(stderr, "kernel_launch: hipFuncSetAttribute failed\n"); grid = -1; return; }
        if (hipOccupancyMaxActiveBlocksPerMultiprocessor(&per_cu, (const void*)mega_fwd, NWAVES * 64, LDS_BYTES) != hipSuccess || per_cu < 1)
            fprintf(stderr, "kernel_launch: occupancy query reports %d workgroups per CU\n", per_cu);
        (void)hipGetLastError();
        grid = cus;
    }
    if (grid < 0) return;
    if (hipMemsetAsync((char*)d_ws + WS_CTL, 0, CTL_ZERO_BYTES, stream) != hipSuccess) return;
    Args a{};
    for (int i = 0; i < 22; ++i) a.in[i] = (const float*)d_in[i];
    a.out = (float*)d_out; a.ws = (unsigned char*)d_ws; a.pad = 0;
#if MK_ONE_LAUNCH
    a.s_lo = 0; a.s_hi = NSTEP; a.li = 0;
    hipLaunchKernelGGL(mega_fwd, dim3(grid), dim3(NWAVES * 64), LDS_BYTES, stream, a);
#else
    for (int s = 0; s < NSTEP; ++s) {
        a.s_lo = s; a.s_hi = s + 1; a.li = s;
        hipLaunchKernelGGL(mega_fwd, dim3(grid), dim3(NWAVES * 64), LDS_BYTES, stream, a);
    }
#endif
}
```
